# Optimizing an MI355X kernel written in HIP

```python
import math
import jax, jax.numpy as jnp
from jax import lax
import numpy as np

D_MODEL = 1024
BATCH = 4
SEQ = 8192
DEPTH = 2
DEC_BATCH = 8
DEC_SEQ = 4096
PAST_LEN = 128

N_AB = (DEPTH + 1) // 2
N_C = DEPTH // 2

CONV_WIDTH = D_MODEL // 2
CONV_KERNEL = 31
HYENA_WIDTH = D_MODEL // 2
HYENA_ORDER = 2
HYENA_IN = (HYENA_ORDER + 1) * HYENA_WIDTH
SHORT_KERNEL = 3
HYENA_EMB_DIM = 33
HYENA_FILTER_HIDDEN = 64
HYENA_DECAY_TARGET = 1e-2
HYENA_FAST_DECAY_PCT = 0.3
HYENA_SLOW_DECAY_PCT = 1.5
N_FILTER_CH = 2 * HYENA_ORDER * HYENA_WIDTH
AB_IN_WIDTH = 2 * CONV_WIDTH + HYENA_IN
N_HEADS = 16
N_KV_HEADS = 4
HEAD_DIM = 64
GROUP = N_HEADS // N_KV_HEADS
ROT_DIM = HEAD_DIM // 4
ROPE_THETA = 500000.0
WINDOW = 128
BLOCK = 128
QKV_WIDTH = (N_HEADS + 2 * N_KV_HEADS) * HEAD_DIM
D_FF = 4 * D_MODEL
NORM_EPS = 1e-5
LN_EPS = 1e-5
FILTER_EPS = 1e-6

kernel_name = 'hybrid_conformer_hyena_swa_encoder'


def rms_norm(x, g):
    xf = x.astype(jnp.float32)
    y = xf * lax.rsqrt(jnp.mean(xf * xf, axis=-1, keepdims=True) + NORM_EPS)
    return (y * g.astype(jnp.float32)).astype(x.dtype)


def layer_norm(x, g, b):
    xf = x.astype(jnp.float32)
    mu = jnp.mean(xf, axis=-1, keepdims=True)
    var = jnp.mean(jnp.square(xf - mu), axis=-1, keepdims=True)
    y = (xf - mu) * lax.rsqrt(var + LN_EPS)
    return (y * g.astype(jnp.float32) + b.astype(jnp.float32)).astype(x.dtype)


def depthwise_conv(x, w, b):
    k, c = w.shape
    pad = k // 2
    y = lax.conv_general_dilated(
        x, w[:, None, :].astype(x.dtype), window_strides=(1,), padding=[(pad, pad)],
        dimension_numbers=('NWC', 'WIO', 'NWC'), feature_group_count=c)
    return y + b.astype(x.dtype)


def conformer_conv(u, w_dw, b_dw, ln_g, ln_b):
    a, gate = jnp.split(u, 2, axis=-1)
    h = a * jax.nn.sigmoid(gate)
    h = depthwise_conv(h, w_dw, b_dw)
    h = layer_norm(h, ln_g, ln_b)
    return jax.nn.silu(h)


def hyena_filters(L, w1, b1, w2, b2, w3, b3, w4, freq, decay):
    f32 = jnp.float32
    t = jnp.linspace(0.0, 1.0, L, dtype=f32)[:, None]
    bands = (HYENA_EMB_DIM - 1) // 2
    w = 2.0 * math.pi * jnp.arange(L, dtype=f32) / L
    f = jnp.linspace(1e-4, bands - 1, bands, dtype=f32)
    fw = w[:, None] * f[None, :]
    z = jnp.concatenate([t, jnp.cos(fw), -jnp.sin(fw)], axis=-1)
    fr = freq.astype(f32)
    h = jnp.sin(fr[0] * (z @ w1.astype(f32) + b1.astype(f32)))
    h = jnp.sin(fr[1] * (h @ w2.astype(f32) + b2.astype(f32)))
    h = jnp.sin(fr[2] * (h @ w3.astype(f32) + b3.astype(f32)))
    h = h @ w4.astype(f32)
    h = h * jnp.exp(-t * jnp.abs(decay.astype(f32)))
    h = h.reshape(L, HYENA_ORDER, 2, HYENA_WIDTH)
    fwd, bwd = h[:, :, 0], h[:, :, 1]
    zero = jnp.zeros((1, HYENA_ORDER, HYENA_WIDTH), f32)
    k = jnp.concatenate([fwd, zero, bwd[:0:-1]], axis=0)
    k = k * lax.rsqrt(jnp.sum(k * k, axis=0, keepdims=True) + FILTER_EPS)
    return k


def hyena(u, short_w, short_b, w1, b1, w2, b2, w3, b3, w4, freq, decay, skip):
    L = u.shape[1]
    u = depthwise_conv(u, short_w, short_b)
    x1, x2, v = jnp.split(u, 3, axis=-1)
    k = hyena_filters(L, w1, b1, w2, b2, w3, b3, w4, freq, decay)
    k_f = jnp.fft.rfft(k, axis=0)
    sk = skip.astype(jnp.float32)
    z = v.astype(jnp.float32)
    for n, gate in enumerate((x1, x2)):
        zf = jnp.fft.rfft(z, n=2 * L, axis=1)
        y = jnp.fft.irfft(zf * k_f[None, :, n, :], n=2 * L, axis=1)[:, :L]
        z = gate.astype(jnp.float32) * (y + z * sk[n])
    return z.astype(u.dtype)


def ab_mixer(h, w_in, cv_dw_w, cv_dw_b, cv_ln_g, cv_ln_b, hy_short_w, hy_short_b,
             hy_w1, hy_b1, hy_w2, hy_b2, hy_w3, hy_b3, hy_w4, hy_freq, hy_decay, hy_skip, w_out):
    u = h @ w_in
    y_a = conformer_conv(u[..., :2 * CONV_WIDTH], cv_dw_w, cv_dw_b, cv_ln_g, cv_ln_b)
    y_b = hyena(u[..., 2 * CONV_WIDTH:], hy_short_w, hy_short_b, hy_w1, hy_b1, hy_w2, hy_b2,
                hy_w3, hy_b3, hy_w4, hy_freq, hy_decay, hy_skip)
    return jnp.concatenate([y_a, y_b], axis=-1) @ w_out


def rope_partial(x):
    L = x.shape[1]
    inv = ROPE_THETA ** (-(jnp.arange(0, ROT_DIM, 2, dtype=jnp.float32) / ROT_DIM))
    ang = jnp.arange(L, dtype=jnp.float32)[:, None] * inv[None, :]
    cos = jnp.cos(ang)[None, :, None, :]
    sin = jnp.sin(ang)[None, :, None, :]
    xr = x[..., :ROT_DIM].astype(jnp.float32)
    a, b = xr[..., :ROT_DIM // 2], xr[..., ROT_DIM // 2:]
    rot = jnp.concatenate([a * cos - b * sin, b * cos + a * sin], axis=-1)
    return jnp.concatenate([rot.astype(x.dtype), x[..., ROT_DIM:]], axis=-1)


def window_attention(h, w_qkv, sink, w_o):
    B, L, _ = h.shape
    nb = L // BLOCK
    qkv = h @ w_qkv
    q = qkv[..., :N_HEADS * HEAD_DIM].reshape(B, L, N_HEADS, HEAD_DIM)
    k = qkv[..., N_HEADS * HEAD_DIM:(N_HEADS + N_KV_HEADS) * HEAD_DIM].reshape(B, L, N_KV_HEADS, HEAD_DIM)
    v = qkv[..., (N_HEADS + N_KV_HEADS) * HEAD_DIM:].reshape(B, L, N_KV_HEADS, HEAD_DIM)
    q = rope_partial(q)
    k = rope_partial(k)
    qb = q.reshape(B, nb, BLOCK, N_KV_HEADS, GROUP, HEAD_DIM)
    padw = ((0, 0), (BLOCK, BLOCK), (0, 0), (0, 0))
    kp = jnp.pad(k, padw).reshape(B, nb + 2, BLOCK, N_KV_HEADS, HEAD_DIM)
    vp = jnp.pad(v, padw).reshape(B, nb + 2, BLOCK, N_KV_HEADS, HEAD_DIM)
    kb = jnp.concatenate([kp[:, :-2], kp[:, 1:-1], kp[:, 2:]], axis=2)
    vb = jnp.concatenate([vp[:, :-2], vp[:, 1:-1], vp[:, 2:]], axis=2)
    s = jnp.einsum('bnqkgd,bnskd->bnkgqs', qb, kb,
                   preferred_element_type=jnp.float32) * (HEAD_DIM ** -0.5)
    qpos = jnp.arange(nb)[:, None] * BLOCK + jnp.arange(BLOCK)[None, :]
    kpos = jnp.arange(nb)[:, None] * BLOCK - BLOCK + jnp.arange(3 * BLOCK)[None, :]
    rel = kpos[:, None, :] - qpos[:, :, None]
    valid = (jnp.abs(rel) <= WINDOW) & (kpos >= 0)[:, None, :] & (kpos < L)[:, None, :]
    s = jnp.where(valid[None, :, None, None], s, -jnp.inf)
    sink_b = sink.astype(jnp.float32).reshape(N_KV_HEADS, GROUP)[None, None, :, :, None]
    m = jnp.maximum(jnp.max(s, axis=-1), sink_b)
    p = jnp.exp(s - m[..., None])
    denom = jnp.sum(p, axis=-1) + jnp.exp(sink_b - m)
    p = (p / denom[..., None]).astype(vb.dtype)
    o = jnp.einsum('bnkgqs,bnskd->bnqkgd', p, vb)
    return o.reshape(B, L, N_HEADS * HEAD_DIM) @ w_o


def sq_relu_mlp(h, w_up, w_down):
    return jnp.square(jax.nn.relu(h @ w_up)) @ w_down


def trunk(x, norm_mix, norm_mlp, norm_final, ab_w_in, ab_w_out, cv_dw_w, cv_dw_b, cv_ln_g, cv_ln_b,
          hy_short_w, hy_short_b, hy_w1, hy_b1, hy_w2, hy_b2, hy_w3, hy_b3, hy_w4, hy_freq,
          hy_decay, hy_skip, at_w_qkv, at_sink, at_w_o, mlp_w_up, mlp_w_down):
    for i in range(DEPTH):
        j = i // 2
        hn = rms_norm(x, norm_mix[i])
        if i % 2 == 0:
            x = x + ab_mixer(hn, ab_w_in[j], cv_dw_w[j], cv_dw_b[j], cv_ln_g[j], cv_ln_b[j],
                             hy_short_w[j], hy_short_b[j], hy_w1[j], hy_b1[j], hy_w2[j], hy_b2[j],
                             hy_w3[j], hy_b3[j], hy_w4[j], hy_freq[j], hy_decay[j], hy_skip[j],
                             ab_w_out[j])
        else:
            x = x + window_attention(hn, at_w_qkv[j], at_sink[j], at_w_o[j])
        hn = rms_norm(x, norm_mlp[i])
        x = x + sq_relu_mlp(hn, mlp_w_up[i], mlp_w_down[i])
    return rms_norm(x, norm_final)


def setup_inputs(seed: int = 0) -> dict:
    key = jax.random.key(seed)
    ks = jax.random.split(key, 32)
    f32 = jnp.float32

    def nrm(k, shape, scale):
        return jax.random.normal(k, shape, f32) * scale

    max_decay = math.log(HYENA_DECAY_TARGET) / HYENA_FAST_DECAY_PCT
    min_decay = math.log(HYENA_DECAY_TARGET) / HYENA_SLOW_DECAY_PCT
    base = jnp.tile(jnp.linspace(min_decay, max_decay, HYENA_WIDTH, dtype=f32), 2 * HYENA_ORDER)
    FH = HYENA_FILTER_HIDDEN
    return {
        'x_prompt': nrm(ks[0], (BATCH, SEQ, D_MODEL), 1.0),
        'x_sample': nrm(ks[1], (DEC_BATCH, DEC_SEQ, D_MODEL), 1.0),
        'norm_mix': 1.0 + nrm(ks[2], (DEPTH, D_MODEL), 0.02),
        'norm_mlp': 1.0 + nrm(ks[3], (DEPTH, D_MODEL), 0.02),
        'norm_final': 1.0 + nrm(ks[4], (D_MODEL,), 0.02),
        'ab_w_in': nrm(ks[5], (N_AB, D_MODEL, AB_IN_WIDTH), D_MODEL ** -0.5),
        'ab_w_out': nrm(ks[6], (N_AB, D_MODEL, D_MODEL), D_MODEL ** -0.5),
        'cv_dw_w': nrm(ks[7], (N_AB, CONV_KERNEL, CONV_WIDTH), CONV_KERNEL ** -0.5),
        'cv_dw_b': nrm(ks[8], (N_AB, CONV_WIDTH), 0.02),
        'cv_ln_g': 1.0 + nrm(ks[9], (N_AB, CONV_WIDTH), 0.02),
        'cv_ln_b': nrm(ks[10], (N_AB, CONV_WIDTH), 0.02),
        'hy_short_w': nrm(ks[11], (N_AB, SHORT_KERNEL, HYENA_IN), SHORT_KERNEL ** -0.5),
        'hy_short_b': nrm(ks[12], (N_AB, HYENA_IN), 0.02),
        'hy_w1': nrm(ks[13], (N_AB, HYENA_EMB_DIM, FH), HYENA_EMB_DIM ** -0.5),
        'hy_b1': nrm(ks[14], (N_AB, FH), 0.02),
        'hy_w2': nrm(ks[15], (N_AB, FH, FH), FH ** -0.5),
        'hy_b2': nrm(ks[16], (N_AB, FH), 0.02),
        'hy_w3': nrm(ks[17], (N_AB, FH, FH), FH ** -0.5),
        'hy_b3': nrm(ks[18], (N_AB, FH), 0.02),
        'hy_w4': nrm(ks[19], (N_AB, FH, N_FILTER_CH), FH ** -0.5),
        'hy_freq': 1.0 + nrm(ks[20], (N_AB, 3, FH), 0.1),
        'hy_decay': base[None, :] * (1.0 + nrm(ks[21], (N_AB, N_FILTER_CH), 0.05)),
        'hy_skip': nrm(ks[22], (N_AB, HYENA_ORDER, HYENA_WIDTH), 0.5),
        'at_w_qkv': nrm(ks[23], (N_C, D_MODEL, QKV_WIDTH), D_MODEL ** -0.5),
        'at_sink': nrm(ks[24], (N_C, N_HEADS), 0.5),
        'at_w_o': nrm(ks[25], (N_C, N_HEADS * HEAD_DIM, D_MODEL), (N_HEADS * HEAD_DIM) ** -0.5),
        'mlp_w_up': nrm(ks[26], (DEPTH, D_MODEL, D_FF), D_MODEL ** -0.5),
        'mlp_w_down': nrm(ks[27], (DEPTH, D_FF, D_MODEL), D_FF ** -0.5),
    }


def reference(x_prompt, x_sample, norm_mix, norm_mlp, norm_final, ab_w_in, ab_w_out, cv_dw_w, cv_dw_b,
              cv_ln_g, cv_ln_b, hy_short_w, hy_short_b, hy_w1, hy_b1, hy_w2, hy_b2, hy_w3, hy_b3, hy_w4,
              hy_freq, hy_decay, hy_skip, at_w_qkv, at_sink, at_w_o, mlp_w_up, mlp_w_down):
    weights = (norm_mix, norm_mlp, norm_final, ab_w_in, ab_w_out, cv_dw_w, cv_dw_b, cv_ln_g, cv_ln_b,
               hy_short_w, hy_short_b, hy_w1, hy_b1, hy_w2, hy_b2, hy_w3, hy_b3, hy_w4, hy_freq,
               hy_decay, hy_skip, at_w_qkv, at_sink, at_w_o, mlp_w_up, mlp_w_down)
    y_prompt = trunk(x_prompt, *weights)
    y_sample = trunk(x_sample, *weights)
    return (y_prompt, y_sample)
```

```cpp
#include <hip/hip_runtime.h>
#include <hip/hip_cooperative_groups.h>
#include <cstdio>
namespace cg = cooperative_groups;

#ifndef MK_MULTI
#define MK_MULTI 0
#endif

#define LAS __attribute__((address_space(3)))
#if defined(__HIP_DEVICE_COMPILE__)
#define LAUNDER(x) asm volatile("" : "+v"(x))
#else
#define LAUNDER(x)
#endif
typedef unsigned short bf16_t;
typedef short bf16x8 __attribute__((ext_vector_type(8)));
typedef short bf16x4 __attribute__((ext_vector_type(4)));
typedef float f32x4 __attribute__((ext_vector_type(4)));
typedef unsigned u32x4 __attribute__((ext_vector_type(4)));
typedef unsigned u32x2 __attribute__((ext_vector_type(2)));

constexpr int NT = 512;
constexpr int NTOK = 65536;
constexpr int DM = 1024;
constexpr int LDS_X_BYTES = (16384 + 1024) * 8;
constexpr int LDS_BYTES = LDS_X_BYTES + 2048;

constexpr size_t N_WIN = 2560ull * 1024, N_WSQ = 1024ull * 1024, N_WQKV = 1536ull * 1024, N_WFF = 4096ull * 1024;
constexpr size_t OFF_WIN = 0;
constexpr size_t OFF_WOUT = OFF_WIN + N_WIN * 2;
constexpr size_t OFF_WQKV = OFF_WOUT + N_WSQ * 2;
constexpr size_t OFF_WO = OFF_WQKV + N_WQKV * 2;
constexpr size_t OFF_WUP = OFF_WO + N_WSQ * 2;
constexpr size_t OFF_WDN = OFF_WUP + 2 * N_WFF * 2;
constexpr size_t OFF_H3 = OFF_WDN + 2 * N_WFF * 2;
constexpr size_t OFF_HN = OFF_H3 + 12288ull * 64 * 4;
constexpr size_t OFF_BIG = OFF_HN + (size_t)NTOK * 1024 * 2;
constexpr size_t OFF_SPEC = OFF_BIG + (size_t)NTOK * 1536 * 2;
constexpr size_t OFF_ZST = OFF_BIG + 268435456ull;
constexpr size_t WS_END = OFF_ZST + 256ull * 8192 * 8;

struct Params {
    const float* in[28];
    float* out;
    unsigned char* ws;
    int ph_lo, ph_hi;
};

__device__ __forceinline__ float bf2f(bf16_t b) { return __uint_as_float(((unsigned)b) << 16); }
__device__ __forceinline__ bf16_t f2bf(float f) { unsigned u = __float_as_uint(f); u += 0x7FFFu + ((u >> 16) & 1u); return (bf16_t)(u >> 16); }
__device__ __forceinline__ unsigned pk2(float lo, float hi) { return (unsigned)f2bf(lo) | ((unsigned)f2bf(hi) << 16); }
__device__ __forceinline__ float wave_sum(float v) {
#pragma unroll
    for (int o = 32; o >= 1; o >>= 1) v += __shfl_xor(v, o, 64);
    return v;
}
__device__ __forceinline__ void seq_of_row(int row, int& L, int& row0) {
    if (row < 32768) { L = 8192; row0 = row & ~8191; } else { L = 4096; row0 = 32768 + ((row - 32768) & ~4095); }
}

namespace pg8 {
constexpr int BM = 256, BK = 64, HALF = 128, HTB = HALF * BK * 2, STAGE_BYTES = 8 * HTB, NXCD = 8, WGM = 8;
__device__ __forceinline__ int lds_byte(int r, int c) { const int st = (r >> 4) * 2 + (c >> 5), rr = r & 15, cc = c & 31, ob = rr * 64 + cc * 2; return st * 1024 + (ob ^ (((ob >> 9) & 1) << 5)); }
__device__ __forceinline__ void stage_rc(int b, int& R, int& C) { const int st = b / 1024, sb = b % 1024, swz = sb ^ (((sb >> 9) & 1) << 5); R = (st >> 1) * 16 + swz / 64; C = (st & 1) * 32 + (swz % 64) / 2; }
__device__ __forceinline__ int perm32(int rho) { const int n = rho >> 4, i = rho & 15; return 8 * (i >> 2) + 4 * n + (i & 3); }
struct Unit { int pm, pn; };
struct Gemm { const bf16_t* A; const bf16_t* Bt; int M, N, K; };
struct StaticOrder {
    int nM, nN, nwg, G, c;
    __device__ __forceinline__ void init(int M, int N, int G_, int c_) { nM = M / BM; nN = N / BM; nwg = nM * nN; G = G_; c = c_; }
    __device__ __forceinline__ bool next(int i, Unit& u) const {
        const long L = (long)i * G + c; if (L >= nwg) return false;
        int wgid = (int)L; { const int q = nwg / NXCD, r = nwg % NXCD, xcd = wgid % NXCD, off = wgid / NXCD; wgid = (xcd < r ? xcd * (q + 1) : r * (q + 1) + (xcd - r) * q) + off; }
        const int nig = WGM * nN, gid = wgid / nig, fm = gid * WGM, gsz = (nM - fm) < WGM ? (nM - fm) : WGM;
        u.pm = fm + ((wgid % nig) % gsz); u.pn = (wgid % nig) / gsz; return true;
    }
};

struct EpiBf {
    static constexpr bool PERM = true;
    int mode; bf16_t* O; int ldc; bf16_t* O2;
    __device__ __forceinline__ void operator()(const f32x4 (&acc)[2][2][4][2], const Unit& u, int wr, int wc, int fr, int fq) const {
        const int row0 = u.pm * BM + wr * 64 + fr, colt = u.pn * BM;
#pragma unroll
        for (int ai = 0; ai < 2; ++ai)
#pragma unroll
            for (int m = 0; m < 4; ++m) {
                const size_t row = (size_t)(row0 + ai * HALF + m * 16);
#pragma unroll
                for (int bj = 0; bj < 2; ++bj) {
                    const int c0 = colt + bj * HALF + wc * 32 + 8 * fq;
                    f32x4 v0 = acc[ai][bj][m][0], v1 = acc[ai][bj][m][1];
                    if (mode == 2) {
                        if (colt < 1024) {
                            float h[4];
#pragma unroll
                            for (int i = 0; i < 4; ++i) h[i] = v0[i] / (1.0f + __expf(-v1[i]));
                            u32x2 o; o.x = pk2(h[0], h[1]); o.y = pk2(h[2], h[3]);
                            *(u32x2*)(O + row * 512 + (c0 >> 1)) = o;
                        } else {
                            u32x4 o; o.x = pk2(v0[0], v0[1]); o.y = pk2(v0[2], v0[3]); o.z = pk2(v1[0], v1[1]); o.w = pk2(v1[2], v1[3]);
                            *(u32x4*)(O2 + row * 1536 + (c0 - 1024)) = o;
                        }
                    } else {
                        if (mode == 1) {
#pragma unroll
                            for (int i = 0; i < 4; ++i) { float a = fmaxf(v0[i], 0.f), b = fmaxf(v1[i], 0.f); v0[i] = a * a; v1[i] = b * b; }
                        }
                        u32x4 o; o.x = pk2(v0[0], v0[1]); o.y = pk2(v0[2], v0[3]); o.z = pk2(v1[0], v1[1]); o.w = pk2(v1[2], v1[3]);
                        *(u32x4*)(O + row * ldc + c0) = o;
                    }
                }
            }
    }
};
struct EpiRes {
    static constexpr bool PERM = false;
    const float* res0; const float* res1; float* out; int row_off;
    __device__ __forceinline__ void operator()(const f32x4 (&acc)[2][2][4][2], const Unit& u, int wr, int wc, int fr, int fq) const {
        const int row0 = row_off + u.pm * BM + wr * 64 + fr, col0 = u.pn * BM + wc * 32 + 4 * fq;
#pragma unroll
        for (int ai = 0; ai < 2; ++ai)
#pragma unroll
            for (int m = 0; m < 4; ++m) {
                const int row = row0 + ai * HALF + m * 16;
                const float* rp = (row < 32768) ? res0 + (size_t)row * 1024 : res1 + (size_t)(row - 32768) * 1024;
                float* op = out + (size_t)row * 1024;
#pragma unroll
                for (int bj = 0; bj < 2; ++bj)
#pragma unroll
                    for (int n = 0; n < 2; ++n) { const int c = col0 + bj * HALF + n * 16; *(f32x4*)(op + c) = *(const f32x4*)(rp + c) + acc[ai][bj][m][n]; }
            }
    }
};

template <class Epi>
__device__ __forceinline__ void gemm_phase(LAS unsigned char* lds, const Gemm g, const StaticOrder& S, const Epi& E) {
    int tid = threadIdx.x; LAUNDER(tid);
    const int wid = __builtin_amdgcn_readfirstlane(tid >> 6), lane = tid & 63, wr = wid >> 2, wc = wid & 3, fr = lane & 15, fq = lane >> 4;
    const int K = g.K, nt = K / BK;
    unsigned voffA[2], voffB[2];
#pragma unroll
    for (int i = 0; i < 2; ++i) { int R, C; stage_rc(tid * 16 + i * 8192, R, C); const int Rb = Epi::PERM ? ((R & ~31) + perm32(R & 31)) : R;
        voffA[i] = (unsigned)(R * K + C) * 2u; voffB[i] = (unsigned)(Rb * K + C) * 2u; }
    const size_t kstep = (size_t)(BK * 2);
    const size_t hstep = (size_t)HALF * K * 2;
    const size_t tstep = 2 * hstep;
    const unsigned ldsw = (unsigned)wid * 1024u;
    const int aoff = lds_byte(wr * 64 + fr, fq * 8), boff = lds_byte(wc * 32 + fr, fq * 8);
#define PG8_SA(b, h) (((b) * 2 + (h)) * HTB)
#define PG8_SB(b, h) ((4 + (b) * 2 + (h)) * HTB)
#define PG8_STAGE(bufoff, gbase, voff) do { _Pragma("unroll") for (int _i = 0; _i < 2; ++_i) \
        __builtin_amdgcn_global_load_lds((const unsigned*)((const char*)(gbase) + (voff)[_i]), (LAS unsigned*)(lds + (bufoff) + ldsw + _i * 8192), 16, 0, 0); } while (0)
#define PG8_LDA(dst, b, h) do { _Pragma("unroll") for (int m = 0; m < 4; ++m) _Pragma("unroll") for (int k = 0; k < 2; ++k) dst[m][k] = *(const LAS bf16x8*)(lds + PG8_SA(b, h) + aoff + m * 2048 + k * 1024); } while (0)
#define PG8_LDB(dst, b, h) do { _Pragma("unroll") for (int n = 0; n < 2; ++n) _Pragma("unroll") for (int k = 0; k < 2; ++k) dst[n][k] = *(const LAS bf16x8*)(lds + PG8_SB(b, h) + boff + n * 2048 + k * 1024); } while (0)
#define PG8_MMA(ai, bj, At, Bt) do { __builtin_amdgcn_s_setprio(1); _Pragma("unroll") for (int m = 0; m < 4; ++m) _Pragma("unroll") for (int n = 0; n < 2; ++n) _Pragma("unroll") for (int k = 0; k < 2; ++k) \
        acc[ai][bj][m][n] = __builtin_amdgcn_mfma_f32_16x16x32_bf16(Bt[n][k], At[m][k], acc[ai][bj][m][n], 0, 0, 0); __builtin_amdgcn_s_setprio(0); } while (0)
#define PG8_WAIT_V(n) asm volatile("s_waitcnt vmcnt(" #n ")" ::: "memory")
#define PG8_WAIT_L(n) asm volatile("s_waitcnt lgkmcnt(" #n ")" ::: "memory")
#define PG8_BAR __builtin_amdgcn_s_barrier()
#define PG8_SCHED __builtin_amdgcn_sched_barrier(0)
    Unit cur, nxt; int ui = 0;
    if (!S.next(0, cur)) return;
    f32x4 acc[2][2][4][2];
#pragma unroll
    for (int a = 0; a < 2; ++a)
#pragma unroll
        for (int b = 0; b < 2; ++b)
#pragma unroll
            for (int m = 0; m < 4; ++m)
#pragma unroll
                for (int n = 0; n < 2; ++n) acc[a][b][m][n] = (f32x4){0.f, 0.f, 0.f, 0.f};
    bf16x8 At[4][2], B0[2][2], B1[2][2];
    const char* cA = (const char*)g.A + (size_t)cur.pm * tstep; const char* cB = (const char*)g.Bt + (size_t)cur.pn * tstep;
    PG8_STAGE(PG8_SB(0, 0), cB, voffB); PG8_STAGE(PG8_SA(0, 0), cA, voffA); PG8_STAGE(PG8_SB(0, 1), cB + hstep, voffB); PG8_STAGE(PG8_SA(0, 1), cA + hstep, voffA);
    if (wr == 1) PG8_BAR;
    PG8_WAIT_V(4); PG8_BAR;
    PG8_STAGE(PG8_SB(1, 0), cB + kstep, voffB); PG8_STAGE(PG8_SA(1, 0), cA + kstep, voffA); PG8_STAGE(PG8_SB(1, 1), cB + hstep + kstep, voffB);
    PG8_WAIT_V(6); PG8_BAR;
    for (;;) {
        const bool has_next = S.next(ui + 1, nxt);
        const char* nA = has_next ? (const char*)g.A + (size_t)nxt.pm * tstep : cA; const char* nB = has_next ? (const char*)g.Bt + (size_t)nxt.pn * tstep : cB;
        for (int t = 0; t < nt; t += 2) {
            const bool last = (t == nt - 2);
            const char* a1 = cA + (size_t)(t + 1) * kstep;
            const char* a2 = last ? nA : cA + (size_t)(t + 2) * kstep; const char* b2 = last ? nB : cB + (size_t)(t + 2) * kstep;
            const char* a3 = a2 + kstep; const char* b3 = b2 + kstep;
            PG8_LDB(B0, 0, 0); PG8_SCHED; PG8_LDA(At, 0, 0); PG8_STAGE(PG8_SA(1, 1), a1 + hstep, voffA);
            PG8_WAIT_L(8); PG8_BAR; PG8_WAIT_L(0); PG8_MMA(0, 0, At, B0); PG8_BAR; PG8_SCHED;
            PG8_LDB(B1, 0, 1); PG8_STAGE(PG8_SB(0, 0), b2, voffB);
            PG8_BAR; PG8_WAIT_L(0); PG8_MMA(0, 1, At, B1); PG8_BAR;
            PG8_LDA(At, 0, 1); PG8_STAGE(PG8_SA(0, 0), a2, voffA);
            PG8_BAR; PG8_WAIT_L(0); PG8_MMA(1, 0, At, B0); PG8_BAR; PG8_SCHED;
            PG8_STAGE(PG8_SB(0, 1), b2 + hstep, voffB);
            PG8_WAIT_V(6); PG8_BAR; PG8_MMA(1, 1, At, B1); PG8_BAR;
            PG8_LDB(B0, 1, 0); PG8_SCHED; PG8_LDA(At, 1, 0); PG8_STAGE(PG8_SA(0, 1), a2 + hstep, voffA);
            PG8_WAIT_L(8); PG8_BAR; PG8_WAIT_L(0); PG8_MMA(0, 0, At, B0); PG8_BAR; PG8_SCHED;
            PG8_LDB(B1, 1, 1); PG8_STAGE(PG8_SB(1, 0), b3, voffB);
            PG8_BAR; PG8_WAIT_L(0); PG8_MMA(0, 1, At, B1); PG8_BAR;
            PG8_LDA(At, 1, 1); PG8_STAGE(PG8_SA(1, 0), a3, voffA);
            PG8_BAR; PG8_WAIT_L(0); PG8_MMA(1, 0, At, B0); PG8_BAR; PG8_SCHED;
            PG8_STAGE(PG8_SB(1, 1), b3 + hstep, voffB);
            PG8_WAIT_V(6); PG8_BAR; PG8_MMA(1, 1, At, B1); PG8_BAR;
        }
        E(acc, cur, wr, wc, fr, fq);
        if (!has_next) break;
#pragma unroll
        for (int a = 0; a < 2; ++a)
#pragma unroll
            for (int b = 0; b < 2; ++b)
#pragma unroll
                for (int m = 0; m < 4; ++m)
#pragma unroll
                    for (int n = 0; n < 2; ++n) acc[a][b][m][n] = (f32x4){0.f, 0.f, 0.f, 0.f};
        cur = nxt; cA = nA; cB = nB; ++ui;
    }
    PG8_WAIT_V(0);
    if (wr == 0) PG8_BAR;
    PG8_BAR;
#undef PG8_SA
#undef PG8_SB
#undef PG8_STAGE
#undef PG8_LDA
#undef PG8_LDB
#undef PG8_MMA
#undef PG8_WAIT_V
#undef PG8_WAIT_L
#undef PG8_BAR
#undef PG8_SCHED
}
}

typedef float cf __attribute__((ext_vector_type(2)));
#define CF(a, b) ((cf){(a), (b)})
__host__ __device__ __forceinline__ cf cmul(cf a, cf b) { return CF(a.x * b.x - a.y * b.y, a.x * b.y + a.y * b.x); }
__host__ __device__ __forceinline__ cf cmulc(cf a, cf b) { return CF(a.x * b.x + a.y * b.y, a.y * b.x - a.x * b.y); }
__host__ __device__ __forceinline__ cf cadd(cf a, cf b) { return CF(a.x + b.x, a.y + b.y); }
__host__ __device__ __forceinline__ cf csub(cf a, cf b) { return CF(a.x - b.x, a.y - b.y); }
__host__ __device__ __forceinline__ int phys(int a) { return a + (a >> 4); }
__host__ __device__ __forceinline__ cf w16(int e) {
    switch (e) {
        case 0: return CF(1.0f, 0.0f);
        case 1: return CF(0.9238795325112867f, -0.3826834323650898f);
        case 2: return CF(0.7071067811865476f, -0.7071067811865476f);
        case 3: return CF(0.3826834323650898f, -0.9238795325112867f);
        case 4: return CF(0.0f, -1.0f);
        case 5: return CF(-0.3826834323650898f, -0.9238795325112867f);
        case 6: return CF(-0.7071067811865476f, -0.7071067811865476f);
        default: return CF(-0.9238795325112867f, -0.3826834323650898f);
    }
}
template <int R> __host__ __device__ __forceinline__ constexpr int bitrev_r(int k) {
    return (R == 2) ? k : (R == 4) ? (((k & 1) << 1) | (k >> 1)) : (((k & 1) << 3) | ((k & 2) << 1) | ((k & 4) >> 1) | ((k & 8) >> 3));
}
template <int R> struct LogR { static constexpr int v = (R == 16) ? 4 : (R == 4) ? 2 : 1; };
__host__ __device__ __forceinline__ cf twiddle_base(int n, int M) {
    float s, c; const float x = 2.0f * (float)n / (float)M;
#if defined(__HIP_DEVICE_COMPILE__)
    s = sinpif(x); c = cospif(x);
#else
    s = (float)sin(3.14159265358979323846 * (double)x); c = (float)cos(3.14159265358979323846 * (double)x);
#endif
    return CF(c, -s);
}
template <int R> __host__ __device__ __forceinline__ void make_tw(cf (&tw)[R], int n, int M) {
    tw[0] = CF(1.f, 0.f);
    if (R > 1) tw[1] = twiddle_base(n, M);
#pragma unroll
    for (int k = 2; k < R; ++k) tw[k] = (k & 1) ? cmul(tw[k - 1], tw[1]) : cmul(tw[k / 2], tw[k / 2]);
}

template <int R, typename XP> __host__ __device__ __forceinline__ void fwd_pass(XP X, int N, int M, int tid) {
    const int m = M / R, ps = (m >= 16) ? m + (m >> 4) : m;
    LAUNDER(tid);
#pragma unroll 1
    for (int g = tid; g < N / R; g += NT) {
        const int n = g % m, B = (g / m) * M, pb = phys(B + n);
        cf v[R];
#pragma unroll
        for (int j = 0; j < R; ++j) v[j] = X[pb + j * ps];
#pragma unroll
        for (int st = 0; st < LogR<R>::v; ++st) {
            const int h = (R / 2) >> st;
#pragma unroll
            for (int j = 0; j < R; ++j) {
                if ((j & h) == 0) {
                    const cf a = v[j], b = v[j + h];
                    v[j] = cadd(a, b);
                    const int e = (j % h) * (16 / (2 * h));
                    v[j + h] = cmul(csub(a, b), w16(e));
                }
            }
        }
        cf tw[R]; make_tw<R>(tw, n, M);
#pragma unroll
        for (int k = 0; k < R; ++k) X[pb + k * ps] = cmul(v[bitrev_r<R>(k)], tw[k]);
    }
}
template <int R, typename XP> __host__ __device__ __forceinline__ void inv_pass(XP X, int N, int M, int tid) {
    const int m = M / R, ps = (m >= 16) ? m + (m >> 4) : m;
    LAUNDER(tid);
#pragma unroll 1
    for (int g = tid; g < N / R; g += NT) {
        const int n = g % m, B = (g / m) * M, pb = phys(B + n);
        cf tw[R]; make_tw<R>(tw, n, M);
        cf v[R];
#pragma unroll
        for (int k = 0; k < R; ++k) v[bitrev_r<R>(k)] = cmulc(X[pb + k * ps], tw[k]);
#pragma unroll
        for (int st = 0; st < LogR<R>::v; ++st) {
            const int h = 1 << st;
#pragma unroll
            for (int j = 0; j < R; ++j) {
                if ((j & h) == 0) {
                    const int e = (j % h) * (16 / (2 * h));
                    const cf a = v[j], b = cmulc(v[j + h], w16(e));
                    v[j] = cadd(a, b); v[j + h] = csub(a, b);
                }
            }
        }
#pragma unroll
        for (int j = 0; j < R; ++j) X[pb + j * ps] = v[j];
    }
}
#if !defined(FFT_HOST_TEST)
#define FFT_SYNC() __syncthreads()
template <int N> __device__ __forceinline__ void fft_fwd(LAS cf* X, int tid) {
    fwd_pass<N / 4096>(X, N, N, tid); FFT_SYNC();
    fwd_pass<16>(X, N, 4096, tid); FFT_SYNC();
    fwd_pass<16>(X, N, 256, tid); FFT_SYNC();
    fwd_pass<16>(X, N, 16, tid); FFT_SYNC();
}
template <int N> __device__ __forceinline__ void fft_inv(LAS cf* X, int tid) {
    inv_pass<16>(X, N, 16, tid); FFT_SYNC();
    inv_pass<16>(X, N, 256, tid); FFT_SYNC();
    inv_pass<16>(X, N, 4096, tid); FFT_SYNC();
    inv_pass<N / 4096>(X, N, N, tid); FFT_SYNC();
}
#endif

#if !defined(FFT_HOST_TEST)
__device__ __forceinline__ void phase_rmsnorm(const float* src0, const float* src1, const float* g, bf16_t* dst_bf, float* dst_f) {
    int tid = threadIdx.x; LAUNDER(tid);
    const int lane = tid & 63, wv = tid >> 6;
    const int gw = blockIdx.x * 8 + wv, nw = gridDim.x * 8;
    f32x4 gv[4];
#pragma unroll
    for (int i = 0; i < 4; ++i) gv[i] = *(const f32x4*)(g + 4 * (lane + 64 * i));
    for (int row = gw; row < NTOK; row += nw) {
        const float* src = (row < 32768) ? src0 + (size_t)row * 1024 : src1 + (size_t)(row - 32768) * 1024;
        f32x4 v[4]; float ss = 0.f;
#pragma unroll
        for (int i = 0; i < 4; ++i) { v[i] = *(const f32x4*)(src + 4 * (lane + 64 * i)); ss += v[i][0] * v[i][0] + v[i][1] * v[i][1] + v[i][2] * v[i][2] + v[i][3] * v[i][3]; }
        ss = wave_sum(ss);
        const float rstd = rsqrtf(ss * (1.0f / 1024.0f) + 1e-5f);
#pragma unroll
        for (int i = 0; i < 4; ++i) {
            f32x4 o = v[i] * rstd * gv[i];
            if (dst_bf) { u32x2 p; p.x = pk2(o[0], o[1]); p.y = pk2(o[2], o[3]); *(u32x2*)(dst_bf + (size_t)row * 1024 + 4 * (lane + 64 * i)) = p; }
            else *(f32x4*)(dst_f + (size_t)row * 1024 + 4 * (lane + 64 * i)) = o;
        }
    }
}

__device__ __forceinline__ void phase_weights(const Params& p, LAS float* T) {
    int tid = threadIdx.x; LAUNDER(tid);
    for (int mi = 0; mi < 8; ++mi) {
        const float* src; bf16_t* dst; int K, N; bool perm = false;
        switch (mi) {
            case 0: src = p.in[5]; dst = (bf16_t*)(p.ws + OFF_WIN); K = 1024; N = 2560; perm = true; break;
            case 1: src = p.in[6]; dst = (bf16_t*)(p.ws + OFF_WOUT); K = 1024; N = 1024; break;
            case 2: src = p.in[23]; dst = (bf16_t*)(p.ws + OFF_WQKV); K = 1024; N = 1536; break;
            case 3: src = p.in[25]; dst = (bf16_t*)(p.ws + OFF_WO); K = 1024; N = 1024; break;
            case 4: src = p.in[26]; dst = (bf16_t*)(p.ws + OFF_WUP); K = 1024; N = 4096; break;
            case 5: src = p.in[26] + N_WFF; dst = (bf16_t*)(p.ws + OFF_WUP) + N_WFF; K = 1024; N = 4096; break;
            case 6: src = p.in[27]; dst = (bf16_t*)(p.ws + OFF_WDN); K = 4096; N = 1024; break;
            default: src = p.in[27] + N_WFF; dst = (bf16_t*)(p.ws + OFF_WDN) + N_WFF; K = 4096; N = 1024; break;
        }
        const int tk = K / 64, tn = N / 64;
        for (int it = blockIdx.x; it < tk * tn; it += gridDim.x) {
            const int k0 = (it / tn) * 64, n0 = (it % tn) * 64;
#pragma unroll
            for (int i = 0; i < 8; ++i) { const int idx = tid + NT * i, r = idx >> 6, c = idx & 63; T[r * 65 + c] = src[(size_t)(k0 + r) * N + n0 + c]; }
            __syncthreads();
#pragma unroll
            for (int i = 0; i < 8; ++i) {
                const int idx = tid + NT * i, nl = idx >> 6, kl = idx & 63; int n = n0 + nl;
                if (perm && n < 1024) { const int nn = n & 511, q = nn >> 2, e = nn & 3; n = 8 * q + e + ((n >= 512) ? 4 : 0); }
                dst[(size_t)n * K + k0 + kl] = f2bf(T[kl * 65 + nl]);
            }
            __syncthreads();
        }
    }
}

__device__ __forceinline__ void phase_filter_hidden(const Params& p) {
    int tid = threadIdx.x; LAUNDER(tid);
    const int lane = tid & 63, wv = tid >> 6;
    const int gw = blockIdx.x * 8 + wv, nw = gridDim.x * 8;
    const float* w1 = p.in[13]; const float* b1 = p.in[14]; const float* w2 = p.in[15]; const float* b2 = p.in[16];
    const float* w3 = p.in[17]; const float* b3 = p.in[18]; const float* fr = p.in[20];
    float* H3 = (float*)(p.ws + OFF_H3);
    for (int pg = gw; pg < 12288; pg += nw) {
        const int L = (pg < 8192) ? 8192 : 4096, pos = (pg < 8192) ? pg : pg - 8192;
        const float t = (float)pos / (float)(L - 1);
        const float w = 6.283185307179586f * (float)pos / (float)L;
        float z = 0.f;
        if (lane == 0) z = t;
        else if (lane <= 32) {
            const int bi = (lane - 1) & 15;
            const float f = 1e-4f + (float)bi * ((15.0f - 1e-4f) / 15.0f);
            const float a = w * f;
            z = (lane <= 16) ? cosf(a) : -sinf(a);
        }
        float a1 = b1[lane];
        for (int i = 0; i < 33; ++i) a1 += __shfl(z, i, 64) * w1[i * 64 + lane];
        const float h1 = sinf(fr[lane] * a1);
        float a2 = b2[lane];
        for (int i = 0; i < 64; ++i) a2 += __shfl(h1, i, 64) * w2[i * 64 + lane];
        const float h2 = sinf(fr[64 + lane] * a2);
        float a3 = b3[lane];
        for (int i = 0; i < 64; ++i) a3 += __shfl(h2, i, 64) * w3[i * 64 + lane];
        const float h3 = sinf(fr[128 + lane] * a3);
        H3[(size_t)pg * 64 + lane] = h3;
    }
}

__device__ __forceinline__ void phase_conformer(const Params& p, LAS unsigned char* lds) {
    int tid = threadIdx.x; LAUNDER(tid);
    const int lane = tid & 63, wv = tid >> 6;
    const bf16_t* HCV = (const bf16_t*)p.out;
    bf16_t* YCAT = (bf16_t*)(p.ws + OFF_HN);
    LAS bf16_t* hb = (LAS bf16_t*)lds;
    LAS float* ob = (LAS float*)(lds + 62 * 512 * 2);
    const float* dw = p.in[7]; const float* db = p.in[8]; const float* lg = p.in[9]; const float* lb = p.in[10];
    float w[31];
#pragma unroll
    for (int k = 0; k < 31; ++k) w[k] = dw[k * 512 + tid];
    const float bias = db[tid];
    float gg[8], bb[8];
#pragma unroll
    for (int i = 0; i < 8; ++i) { gg[i] = lg[lane * 8 + i]; bb[i] = lb[lane * 8 + i]; }
    for (int it = blockIdx.x; it < NTOK / 32; it += gridDim.x) {
        const int rowbase = it * 32; int L, row0; seq_of_row(rowbase, L, row0);
        const int t0 = rowbase - row0;
        for (int idx = tid; idx < 62 * 64; idx += NT) {
            const int r = idx >> 6, c8 = idx & 63, t = t0 - 15 + r;
            u32x4 v = (u32x4){0u, 0u, 0u, 0u};
            if (t >= 0 && t < L) v = *(const u32x4*)(HCV + (size_t)(row0 + t) * 512 + c8 * 8);
            *(LAS u32x4*)(hb + r * 512 + c8 * 8) = v;
        }
        __syncthreads();
        float acc[32];
#pragma unroll
        for (int i = 0; i < 32; ++i) acc[i] = bias;
#pragma unroll
        for (int r = 0; r < 62; ++r) {
            const float val = bf2f(hb[r * 512 + tid]);
#pragma unroll
            for (int tt = 0; tt < 32; ++tt) { if (r - tt >= 0 && r - tt < 31) acc[tt] += w[r - tt] * val; }
        }
#pragma unroll
        for (int tt = 0; tt < 32; ++tt) ob[tt * 512 + tid] = acc[tt];
        __syncthreads();
#pragma unroll
        for (int i = 0; i < 4; ++i) {
            const int tt = wv + 8 * i;
            f32x4 v0 = *(const LAS f32x4*)(ob + tt * 512 + lane * 8), v1 = *(const LAS f32x4*)(ob + tt * 512 + lane * 8 + 4);
            float s = v0[0] + v0[1] + v0[2] + v0[3] + v1[0] + v1[1] + v1[2] + v1[3];
            s = wave_sum(s); const float mu = s * (1.0f / 512.0f);
            float x[8]; float q = 0.f;
#pragma unroll
            for (int j = 0; j < 4; ++j) { x[j] = v0[j] - mu; x[4 + j] = v1[j] - mu; }
#pragma unroll
            for (int j = 0; j < 8; ++j) q += x[j] * x[j];
            q = wave_sum(q); const float rstd = rsqrtf(q * (1.0f / 512.0f) + 1e-5f);
            float y[8];
#pragma unroll
            for (int j = 0; j < 8; ++j) { const float a = x[j] * rstd * gg[j] + bb[j]; y[j] = a / (1.0f + __expf(-a)); }
            u32x4 o; o.x = pk2(y[0], y[1]); o.y = pk2(y[2], y[3]); o.z = pk2(y[4], y[5]); o.w = pk2(y[6], y[7]);
            *(u32x4*)(YCAT + (size_t)(rowbase + tt) * 1024 + lane * 8) = o;
        }
        __syncthreads();
    }
}

__device__ __forceinline__ void phase_shortconv_T(const Params& p, LAS float* U) {
    int tid = threadIdx.x; LAUNDER(tid);
    const bf16_t* UHY = (const bf16_t*)p.out + (size_t)NTOK * 512;
    bf16_t* XT = (bf16_t*)(p.ws + OFF_BIG);
    const float* sw = p.in[11]; const float* sb = p.in[12];
    for (int it = blockIdx.x; it < (NTOK / 64) * 12; it += gridDim.x) {
        const int tile = it / 12, cht = it % 12, rowbase = tile * 64; int L, row0; seq_of_row(rowbase, L, row0);
        const int t0 = rowbase - row0;
        for (int idx = tid; idx < 66 * 16; idx += NT) {
            const int r = idx >> 4, c8 = idx & 15, t = t0 - 1 + r;
            u32x4 v = (u32x4){0u, 0u, 0u, 0u};
            if (t >= 0 && t < L) v = *(const u32x4*)(UHY + (size_t)(row0 + t) * 1536 + cht * 128 + c8 * 8);
            LAS float* d = U + r * 129 + c8 * 8;
            d[0] = __uint_as_float(v.x << 16); d[1] = __uint_as_float(v.x & 0xffff0000u);
            d[2] = __uint_as_float(v.y << 16); d[3] = __uint_as_float(v.y & 0xffff0000u);
            d[4] = __uint_as_float(v.z << 16); d[5] = __uint_as_float(v.z & 0xffff0000u);
            d[6] = __uint_as_float(v.w << 16); d[7] = __uint_as_float(v.w & 0xffff0000u);
        }
        __syncthreads();
        for (int idx = tid; idx < 128 * 64; idx += NT) {
            const int chl = idx >> 6, tl = idx & 63, ch = cht * 128 + chl;
            const float val = sb[ch] + sw[ch] * U[tl * 129 + chl] + sw[1536 + ch] * U[(tl + 1) * 129 + chl] + sw[3072 + ch] * U[(tl + 2) * 129 + chl];
            XT[(size_t)row0 * 1536 + (size_t)ch * L + t0 + tl] = f2bf(val);
        }
        __syncthreads();
    }
}

__device__ __forceinline__ void phase_zT(const Params& p, LAS float* U) {
    int tid = threadIdx.x; LAUNDER(tid);
    const bf16_t* XT = (const bf16_t*)(p.ws + OFF_BIG);
    bf16_t* YCAT = (bf16_t*)(p.ws + OFF_HN);
    for (int it = blockIdx.x; it < (NTOK / 64) * 8; it += gridDim.x) {
        const int tile = it / 8, cht = it % 8, rowbase = tile * 64; int L, row0; seq_of_row(rowbase, L, row0);
        const int t0 = rowbase - row0;
#pragma unroll
        for (int i = 0; i < 8; ++i) {
            const int idx = tid + NT * i, chl = idx >> 6, tl = idx & 63;
            U[chl * 65 + tl] = bf2f(XT[(size_t)row0 * 1536 + (size_t)(1024 + cht * 64 + chl) * L + t0 + tl]);
        }
        __syncthreads();
#pragma unroll
        for (int i = 0; i < 8; ++i) {
            const int idx = tid + NT * i, tl = idx >> 6, chl = idx & 63;
            YCAT[(size_t)(rowbase + tl) * 1024 + 512 + cht * 64 + chl] = f2bf(U[chl * 65 + tl]);
        }
        __syncthreads();
    }
}

__device__ __forceinline__ float block_sum(float v, LAS float* red, int tid) {
    v = wave_sum(v);
    __syncthreads();
    if ((tid & 63) == 0) red[tid >> 6] = v;
    __syncthreads();
    float s = 0.f;
#pragma unroll
    for (int i = 0; i < 8; ++i) s += red[i];
    return s;
}
template <int L> __device__ __forceinline__ void hyena_item(const Params& p, LAS unsigned char* lds, int c) {
    constexpr int N = 2 * L, PT = L / NT;
    constexpr int NSEQ = (L == 8192) ? 4 : 8, SEQ0ROW = (L == 8192) ? 0 : 32768;
    int tid = threadIdx.x; LAUNDER(tid);
    LAS cf* X = (LAS cf*)lds;
    LAS float* w4s = (LAS float*)(lds + LDS_X_BYTES);
    LAS float* red = w4s + 256;
    const float* H3 = (const float*)(p.ws + OFF_H3) + ((L == 8192) ? 0 : 8192 * 64);
    const float* w4 = p.in[19]; const float* decay = p.in[21]; const float* skip = p.in[22];
    cf* SPEC = (cf*)(p.ws + OFF_SPEC) + (size_t)blockIdx.x * 2 * 16384;
    bf16_t* XT = (bf16_t*)(p.ws + OFF_BIG);
    cf* ZST = (cf*)(p.ws + OFF_ZST) + (size_t)blockIdx.x * 8192;
    __syncthreads();
    if (tid < 256) { const int col = (tid >> 6) * 512 + c, j = tid & 63; w4s[tid] = w4[j * 2048 + col]; }
    __syncthreads();
    float dec[4];
#pragma unroll
    for (int q = 0; q < 4; ++q) dec[q] = fabsf(decay[q * 512 + c]);
    float ss0 = 0.f, ss1 = 0.f;
#pragma unroll 1
    for (int i = 0; i < PT; ++i) {
        const int t = tid + NT * i;
        float a0 = 0.f, a1 = 0.f, a2 = 0.f, a3 = 0.f;
        const f32x4* hr = (const f32x4*)(H3 + (size_t)t * 64);
#pragma unroll 4
        for (int j4 = 0; j4 < 16; ++j4) {
            const f32x4 h = hr[j4];
#pragma unroll
            for (int e = 0; e < 4; ++e) { const int j = j4 * 4 + e; a0 += h[e] * w4s[j]; a1 += h[e] * w4s[64 + j]; a2 += h[e] * w4s[128 + j]; a3 += h[e] * w4s[192 + j]; }
        }
        const float tn = (float)t / (float)(L - 1);
        a0 *= __expf(-tn * dec[0]); a1 *= __expf(-tn * dec[1]); a2 *= __expf(-tn * dec[2]); a3 *= __expf(-tn * dec[3]);
        ss0 += a0 * a0 + ((t > 0) ? a1 * a1 : 0.f);
        ss1 += a2 * a2 + ((t > 0) ? a3 * a3 : 0.f);
        X[phys(t)] = CF(a0, 0.f);
        if (t > 0) X[phys(N - t)] = CF(a1, 0.f); else X[phys(L)] = CF(0.f, 0.f);
        SPEC[16384 + t] = CF(a2, a3);
    }
    ss0 = block_sum(ss0, red, tid);
    ss1 = block_sum(ss1, red, tid);
    const float sc0 = rsqrtf(ss0 + 1e-6f) * (1.0f / (float)N), sc1 = rsqrtf(ss1 + 1e-6f) * (1.0f / (float)N);
    __syncthreads();
    fft_fwd<N>(X, tid);
    for (int a = tid; a < N; a += NT) { const cf v = X[phys(a)]; SPEC[a] = CF(v.x * sc0, v.y * sc0); }
    __syncthreads();
#pragma unroll 1
    for (int i = 0; i < PT; ++i) {
        const int t = tid + NT * i;
        const cf fb = SPEC[16384 + t];
        X[phys(t)] = CF(fb.x, 0.f);
        if (t > 0) X[phys(N - t)] = CF(fb.y, 0.f); else X[phys(L)] = CF(0.f, 0.f);
    }
    __syncthreads();
    fft_fwd<N>(X, tid);
    for (int a = tid; a < N; a += NT) { const cf v = X[phys(a)]; SPEC[16384 + a] = CF(v.x * sc1, v.y * sc1); }
    __threadfence_block();
    __syncthreads();
    const float sk0 = skip[c], sk1 = skip[512 + c];
    for (int pr = 0; pr < NSEQ / 2; ++pr) {
        const size_t base0 = (size_t)(SEQ0ROW + (2 * pr) * L) * 1536, base1 = (size_t)(SEQ0ROW + (2 * pr + 1) * L) * 1536;
        const bf16_t* x1a = XT + base0 + (size_t)c * L;            const bf16_t* x1b = XT + base1 + (size_t)c * L;
        const bf16_t* x2a = XT + base0 + (size_t)(512 + c) * L;    const bf16_t* x2b = XT + base1 + (size_t)(512 + c) * L;
        bf16_t* va = XT + base0 + (size_t)(1024 + c) * L;          bf16_t* vb = XT + base1 + (size_t)(1024 + c) * L;
#pragma unroll 2
        for (int i = 0; i < PT; ++i) {
            const int t = tid + NT * i;
            X[phys(t)] = CF(bf2f(va[t]), bf2f(vb[t])); X[phys(L + t)] = CF(0.f, 0.f);
        }
        __syncthreads();
        fft_fwd<N>(X, tid);
#pragma unroll 2
        for (int a = tid; a < N; a += NT) { const int pa = phys(a); X[pa] = cmul(X[pa], SPEC[a]); }
        __syncthreads();
        fft_inv<N>(X, tid);
#pragma unroll 2
        for (int i = 0; i < PT; ++i) {
            const int t = tid + NT * i;
            const cf y = X[phys(t)];
            const cf z1 = CF(bf2f(x1a[t]) * (y.x + bf2f(va[t]) * sk0), bf2f(x1b[t]) * (y.y + bf2f(vb[t]) * sk0));
            ZST[t] = z1;
            X[phys(t)] = z1; X[phys(L + t)] = CF(0.f, 0.f);
        }
        __syncthreads();
        fft_fwd<N>(X, tid);
#pragma unroll 2
        for (int a = tid; a < N; a += NT) { const int pa = phys(a); X[pa] = cmul(X[pa], SPEC[16384 + a]); }
        __syncthreads();
        fft_inv<N>(X, tid);
#pragma unroll 2
        for (int i = 0; i < PT; ++i) {
            const int t = tid + NT * i;
            const cf y = X[phys(t)], z1 = ZST[t];
            va[t] = f2bf(bf2f(x2a[t]) * (y.x + z1.x * sk1)); vb[t] = f2bf(bf2f(x2b[t]) * (y.y + z1.y * sk1));
        }
        __syncthreads();
    }
}
__device__ __forceinline__ void phase_hyena(const Params& p, LAS unsigned char* lds) {
    for (int it = blockIdx.x; it < 1024; it += gridDim.x) {
        if (it < 512) hyena_item<8192>(p, lds, it); else hyena_item<4096>(p, lds, it - 512);
    }
}

__device__ __forceinline__ void rope_angle(int pos, int i, float& cs, float& sn) {
    double iv;
    switch (i) {
        case 0: iv = 0.15915494309189535; break; case 1: iv = 0.03086376340470123; break; case 2: iv = 0.005985185712713705; break; case 3: iv = 0.001160663641240061; break;
        case 4: iv = 0.00022507907903927653; break; case 5: iv = 4.364795279280289e-05; break; case 6: iv = 8.464330808241401e-06; break; default: iv = 1.6414262627950345e-06; break;
    }
    double r = (double)pos * iv; r -= floor(r);
    const float x = 2.0f * (float)r;
    cs = cospif(x); sn = sinpif(x);
}
__device__ __forceinline__ void phase_attn(const Params& p, LAS unsigned char* lds) {
    int tid = threadIdx.x; LAUNDER(tid);
    const int lane = tid & 63, wv = tid >> 6, col = lane & 15, quad = lane >> 4;
    const bf16_t* QKV = (const bf16_t*)(p.ws + OFF_BIG);
    bf16_t* ATT = (bf16_t*)(p.ws + OFF_HN);
    LAS bf16_t* Ks = (LAS bf16_t*)lds;
    LAS bf16_t* Vt = (LAS bf16_t*)(lds + 336 * 72 * 2);
    const float* sink = p.in[24];
    constexpr float LOG2E = 1.4426950408889634f;
    for (int it = blockIdx.x; it < 4096; it += gridDim.x) {
        const int tileIdx = it >> 2, kvh = it & 3;
        int L, row0, q0;
        if (tileIdx < 512) { L = 8192; row0 = (tileIdx >> 7) * 8192; q0 = (tileIdx & 127) * 64; }
        else { const int ti = tileIdx - 512; L = 4096; row0 = 32768 + (ti >> 6) * 4096; q0 = (ti & 63) * 64; }
        const int kstart = q0 - 128;
        __syncthreads();
        for (int u = tid; u < 336 * 4; u += NT) {
            const int key = u >> 2, ch = u & 3, pos = kstart + key;
            u32x4 v0 = (u32x4){0u, 0u, 0u, 0u}, v1 = v0;
            if (pos >= 0 && pos < L) {
                const bf16_t* src = QKV + (size_t)(row0 + pos) * 1536 + 1024 + kvh * 64 + ch * 16;
                v0 = *(const u32x4*)src; v1 = *(const u32x4*)(src + 8);
                if (ch == 0) {
                    float a[8], b[8];
#pragma unroll
                    for (int i = 0; i < 4; ++i) { a[2 * i] = __uint_as_float(v0[i] << 16); a[2 * i + 1] = __uint_as_float(v0[i] & 0xffff0000u); b[2 * i] = __uint_as_float(v1[i] << 16); b[2 * i + 1] = __uint_as_float(v1[i] & 0xffff0000u); }
#pragma unroll
                    for (int i = 0; i < 8; ++i) { float cs, sn; rope_angle(pos, i, cs, sn); const float na = a[i] * cs - b[i] * sn, nb = b[i] * cs + a[i] * sn; a[i] = na; b[i] = nb; }
#pragma unroll
                    for (int i = 0; i < 4; ++i) { v0[i] = pk2(a[2 * i], a[2 * i + 1]); v1[i] = pk2(b[2 * i], b[2 * i + 1]); }
                }
            }
            *(LAS u32x4*)(Ks + key * 72 + ch * 16) = v0; *(LAS u32x4*)(Ks + key * 72 + ch * 16 + 8) = v1;
        }
        for (int u = tid; u < 336 * 8; u += NT) {
            const int key = u >> 3, c8 = u & 7, pos = kstart + key;
            u32x4 v = (u32x4){0u, 0u, 0u, 0u};
            if (pos >= 0 && pos < L) v = *(const u32x4*)(QKV + (size_t)(row0 + pos) * 1536 + 1280 + kvh * 64 + c8 * 8);
#pragma unroll
            for (int i = 0; i < 4; ++i) { Vt[(c8 * 8 + 2 * i) * 344 + key] = (bf16_t)(v[i] & 0xffffu); Vt[(c8 * 8 + 2 * i + 1) * 344 + key] = (bf16_t)(v[i] >> 16); }
        }
        __syncthreads();
#pragma unroll 1
        for (int bi = 0; bi < 2; ++bi) {
            const int blk = wv + 8 * bi, g = blk >> 2, qt = blk & 3, h = kvh * 4 + g, qa = q0 + qt * 16;
            const int qpos = qa + col;
            bf16x8 qf[2];
            {
                const bf16_t* qsrc = QKV + (size_t)(row0 + qpos) * 1536 + h * 64;
                u32x4 r0 = *(const u32x4*)(qsrc + quad * 8), r1 = *(const u32x4*)(qsrc + 32 + quad * 8);
                if (quad < 2) {
                    const u32x4 ra = *(const u32x4*)(qsrc), rb = *(const u32x4*)(qsrc + 8);
                    float a[8], b[8];
#pragma unroll
                    for (int i = 0; i < 4; ++i) { a[2 * i] = __uint_as_float(ra[i] << 16); a[2 * i + 1] = __uint_as_float(ra[i] & 0xffff0000u); b[2 * i] = __uint_as_float(rb[i] << 16); b[2 * i + 1] = __uint_as_float(rb[i] & 0xffff0000u); }
                    float o[8];
#pragma unroll
                    for (int i = 0; i < 8; ++i) { float cs, sn; rope_angle(qpos, i, cs, sn); o[i] = (quad == 0) ? (a[i] * cs - b[i] * sn) : (b[i] * cs + a[i] * sn); }
#pragma unroll
                    for (int i = 0; i < 4; ++i) r0[i] = pk2(o[2 * i], o[2 * i + 1]);
                }
                qf[0] = __builtin_bit_cast(bf16x8, r0); qf[1] = __builtin_bit_cast(bf16x8, r1);
            }
            const int kk0 = qt * 16;
            const float sk2 = sink[h] * LOG2E;
            f32x4 sc[18];
            float mx = -1e30f;
#pragma unroll
            for (int j = 0; j < 18; ++j) {
                f32x4 acc = (f32x4){0.f, 0.f, 0.f, 0.f};
#pragma unroll
                for (int ks = 0; ks < 2; ++ks) {
                    const bf16x8 kf = *(const LAS bf16x8*)(Ks + (kk0 + 16 * j + col) * 72 + ks * 32 + quad * 8);
                    acc = __builtin_amdgcn_mfma_f32_16x16x32_bf16(kf, qf[ks], acc, 0, 0, 0);
                }
#pragma unroll
                for (int i = 0; i < 4; ++i) {
                    const int rel = -128 + 16 * j + 4 * quad + i - col, kpos = qpos + rel;
                    const bool valid = (rel >= -128) && (rel <= 128) && (kpos >= 0) && (kpos < L);
                    const float tv = valid ? acc[i] * (0.125f * LOG2E) : -1e30f;
                    acc[i] = tv; mx = fmaxf(mx, tv);
                }
                sc[j] = acc;
                __builtin_amdgcn_sched_barrier(0);
            }
            mx = fmaxf(mx, __shfl_xor(mx, 16, 64)); mx = fmaxf(mx, __shfl_xor(mx, 32, 64));
            mx = fmaxf(mx, sk2);
            float sum = 0.f;
#pragma unroll
            for (int j = 0; j < 18; ++j)
#pragma unroll
                for (int i = 0; i < 4; ++i) { const float pv = exp2f(sc[j][i] - mx); sc[j][i] = pv; sum += pv; }
            sum += __shfl_xor(sum, 16, 64); sum += __shfl_xor(sum, 32, 64);
            const float rden = 1.0f / (sum + exp2f(sk2 - mx));
            f32x4 oacc[4];
#pragma unroll
            for (int dt = 0; dt < 4; ++dt) oacc[dt] = (f32x4){0.f, 0.f, 0.f, 0.f};
#pragma unroll
            for (int gI = 0; gI < 9; ++gI) {
                u32x4 pb; pb.x = pk2(sc[2 * gI][0], sc[2 * gI][1]); pb.y = pk2(sc[2 * gI][2], sc[2 * gI][3]); pb.z = pk2(sc[2 * gI + 1][0], sc[2 * gI + 1][1]); pb.w = pk2(sc[2 * gI + 1][2], sc[2 * gI + 1][3]);
                const bf16x8 pf = __builtin_bit_cast(bf16x8, pb);
#pragma unroll
                for (int dt = 0; dt < 4; ++dt) {
                    const LAS bf16_t* vp = Vt + (dt * 16 + col) * 344 + kk0 + 32 * gI + 4 * quad;
                    const u32x2 lo = *(const LAS u32x2*)vp, hi = *(const LAS u32x2*)(vp + 16);
                    u32x4 vv; vv.x = lo.x; vv.y = lo.y; vv.z = hi.x; vv.w = hi.y;
                    oacc[dt] = __builtin_amdgcn_mfma_f32_16x16x32_bf16(__builtin_bit_cast(bf16x8, vv), pf, oacc[dt], 0, 0, 0);
                }
                __builtin_amdgcn_sched_barrier(0);
            }
            bf16_t* op = ATT + (size_t)(row0 + qpos) * 1024 + h * 64 + 4 * quad;
#pragma unroll
            for (int dt = 0; dt < 4; ++dt) { u32x2 o; o.x = pk2(oacc[dt][0] * rden, oacc[dt][1] * rden); o.y = pk2(oacc[dt][2] * rden, oacc[dt][3] * rden); *(u32x2*)(op + dt * 16) = o; }
        }
    }
}

#if defined(PHASE_TEST)
#define LDSDECL extern __shared__ __attribute__((aligned(16))) unsigned char lds_raw[]; LAS unsigned char* lds = (LAS unsigned char*)lds_raw
__global__ void __launch_bounds__(NT) k_rms(Params p) { phase_rmsnorm(p.in[0], p.in[1], p.in[2], (bf16_t*)p.ws, nullptr); }
__global__ void __launch_bounds__(NT) k_w(Params p) { LDSDECL; phase_weights(p, (LAS float*)lds); }
__global__ void __launch_bounds__(NT) k_fh(Params p) { phase_filter_hidden(p); }
__global__ void __launch_bounds__(NT) k_conf(Params p) { LDSDECL; phase_conformer(p, lds); }
__global__ void __launch_bounds__(NT) k_sc(Params p) { LDSDECL; phase_shortconv_T(p, (LAS float*)lds); }
__global__ void __launch_bounds__(NT) k_zt(Params p) { LDSDECL; phase_zT(p, (LAS float*)lds); }
__global__ void __launch_bounds__(NT) k_hy(Params p) { LDSDECL; phase_hyena(p, lds); }
__global__ void __launch_bounds__(NT) k_attn(Params p) { LDSDECL; phase_attn(p, lds); }
__global__ void __launch_bounds__(NT) k_gbf(Params p, pg8::Gemm g, pg8::EpiBf e) { LDSDECL; pg8::StaticOrder S; S.init(g.M, g.N, gridDim.x, blockIdx.x); pg8::gemm_phase<pg8::EpiBf>(lds, g, S, e); }
__global__ void __launch_bounds__(NT) k_gres(Params p, pg8::Gemm g, pg8::EpiRes e) { LDSDECL; pg8::StaticOrder S; S.init(g.M, g.N, gridDim.x, blockIdx.x); pg8::gemm_phase<pg8::EpiRes>(lds, g, S, e); }
#endif
constexpr int NPH = 21;
__global__ void __launch_bounds__(NT) mk_fwd(Params p) {
    extern __shared__ __attribute__((aligned(16))) unsigned char lds_raw[];
    LAS unsigned char* lds = (LAS unsigned char*)lds_raw;
    bf16_t* WB = (bf16_t*)p.ws;
    bf16_t* HN = (bf16_t*)(p.ws + OFF_HN);
    bf16_t* BIG = (bf16_t*)(p.ws + OFF_BIG);
    float* X = p.out;
    for (int ph = p.ph_lo; ph < p.ph_hi; ++ph) {
        int kind = 0;
        const float* ng = nullptr;
        pg8::Gemm g{}; pg8::EpiBf eb{}; pg8::EpiRes er{};
        switch (ph) {
            case 0: kind = 10; break;
            case 1: kind = 2; g = pg8::Gemm{HN, (bf16_t*)(p.ws + OFF_WIN), NTOK, 2560, 1024}; eb = pg8::EpiBf{2, (bf16_t*)p.out, 512, (bf16_t*)p.out + (size_t)NTOK * 512}; break;
            case 2: kind = 11; break;
            case 3: kind = 12; break;
            case 4: kind = 13; break;
            case 5: kind = 3; g = pg8::Gemm{HN, (bf16_t*)(p.ws + OFF_WOUT), NTOK, 1024, 1024}; er = pg8::EpiRes{p.in[0], p.in[1], X, 0}; break;
            case 6: kind = 1; ng = p.in[3]; break;
            case 7: case 9: case 16: case 18: {
                const int layer = (ph >= 16), half = (ph == 9 || ph == 18);
                kind = 2; g = pg8::Gemm{HN + (size_t)half * 32768 * 1024, (bf16_t*)(p.ws + OFF_WUP) + (size_t)layer * N_WFF, 32768, 4096, 1024};
                eb = pg8::EpiBf{1, BIG, 4096, nullptr}; break; }
            case 8: case 10: case 17: case 19: {
                const int layer = (ph >= 17), half = (ph == 10 || ph == 19);
                kind = 3; g = pg8::Gemm{BIG, (bf16_t*)(p.ws + OFF_WDN) + (size_t)layer * N_WFF, 32768, 1024, 4096};
                er = pg8::EpiRes{X, X + (size_t)32768 * 1024, X, half * 32768}; break; }
            case 11: kind = 1; ng = p.in[2] + 1024; break;
            case 12: kind = 2; g = pg8::Gemm{HN, (bf16_t*)(p.ws + OFF_WQKV), NTOK, 1536, 1024}; eb = pg8::EpiBf{0, BIG, 1536, nullptr}; break;
            case 13: kind = 14; break;
            case 14: kind = 3; g = pg8::Gemm{HN, (bf16_t*)(p.ws + OFF_WO), NTOK, 1024, 1024}; er = pg8::EpiRes{X, X + (size_t)32768 * 1024, X, 0}; break;
            case 15: kind = 1; ng = p.in[3] + 1024; break;
            case 20: kind = 15; break;
            default: break;
        }
        (void)WB;
        if (kind == 1) phase_rmsnorm(X, X + (size_t)32768 * 1024, ng, HN, nullptr);
        else if (kind == 2) { pg8::StaticOrder S; S.init(g.M, g.N, gridDim.x, blockIdx.x); pg8::gemm_phase<pg8::EpiBf>(lds, g, S, eb); }
        else if (kind == 3) { pg8::StaticOrder S; S.init(g.M, g.N, gridDim.x, blockIdx.x); pg8::gemm_phase<pg8::EpiRes>(lds, g, S, er); }
        else if (kind == 10) { phase_weights(p, (LAS float*)lds); phase_filter_hidden(p); phase_rmsnorm(p.in[0], p.in[1], p.in[2], HN, nullptr); }
        else if (kind == 11) { phase_conformer(p, lds); phase_shortconv_T(p, (LAS float*)lds); }
        else if (kind == 12) phase_hyena(p, lds);
        else if (kind == 13) phase_zT(p, (LAS float*)lds);
        else if (kind == 14) phase_attn(p, lds);
        else if (kind == 15) phase_rmsnorm(X, X + (size_t)32768 * 1024, p.in[4], nullptr, X);
        if (ph + 1 < p.ph_hi) { __threadfence(); cg::this_grid().sync(); }
    }
}

extern "C" void kernel_launch(void* const* d_in, const int* in_sizes, int n_in, void* d_out, int out_size, void* d_ws, size_t ws_size, hipStream_t stream) {
    static int grid = 0;
    if (grid == 0) {
        if (n_in != 28 || ws_size < WS_END) { fprintf(stderr, "kernel_launch: unexpected n_in %d / ws_size %zu (need %zu)\n", n_in, ws_size, (size_t)WS_END); grid = -1; return; }
        int dev = 0, cus = 0, per_cu = 0;
        hipGetDevice(&dev); hipDeviceGetAttribute(&cus, hipDeviceAttributeMultiprocessorCount, dev);
        if (hipFuncSetAttribute((const void*)mk_fwd, hipFuncAttributeMaxDynamicSharedMemorySize, LDS_BYTES) != hipSuccess) { fprintf(stderr, "kernel_launch: hipFuncSetAttribute failed\n"); grid = -1; return; }
        hipOccupancyMaxActiveBlocksPerMultiprocessor(&per_cu, (const void*)mk_fwd, NT, LDS_BYTES);
        if (per_cu < 1) { fprintf(stderr, "kernel_launch: occupancy query says %d blocks per CU\n", per_cu); per_cu = 1; }
        (void)hipGetLastError();
        grid = cus > 256 ? 256 : cus;
    }
    if (grid < 0) return;
    Params p{};
    for (int i = 0; i < 28; ++i) p.in[i] = (const float*)d_in[i];
    p.out = (float*)d_out; p.ws = (unsigned char*)d_ws;
#if MK_MULTI
    for (int ph = 0; ph < NPH; ++ph) {
        p.ph_lo = ph; p.ph_hi = ph + 1;
        hipLaunchKernelGGL(mk_fwd, dim3(grid), dim3(NT), LDS_BYTES, stream, p);
    }
#else
    p.ph_lo = 0; p.ph_hi = NPH;
    void* args[] = {&p};
    hipError_t e = hipLaunchCooperativeKernel((const void*)mk_fwd, dim3(grid), dim3(NT), args, LDS_BYTES, stream);
    if (e != hipSuccess) fprintf(stderr, "cooperative launch failed: %s (grid %d)\n", hipGetErrorString(e), grid);
#endif
}
#endif
```

```cpp
#include <hip/hip_runtime.h>
#include <hip/hip_cooperative_groups.h>
#include <cstdio>
namespace cg = cooperative_groups;

#ifndef MK_MULTI
#define MK_MULTI 0
#endif

#define LAS __attribute__((address_space(3)))
#if defined(__HIP_DEVICE_COMPILE__)
#define LAUNDER(x) asm volatile("" : "+v"(x))
#else
#define LAUNDER(x)
#endif
typedef unsigned short bf16_t;
typedef short bf16x8 __attribute__((ext_vector_type(8)));
typedef short bf16x4 __attribute__((ext_vector_type(4)));
typedef float f32x4 __attribute__((ext_vector_type(4)));
typedef unsigned u32x4 __attribute__((ext_vector_type(4)));
typedef unsigned u32x2 __attribute__((ext_vector_type(2)));

constexpr int NT = 512;
constexpr int NTOK = 65536;
constexpr int DM = 1024;
constexpr int LDS_X_BYTES = (16384 + 1024) * 8;
constexpr int LDS_BYTES = LDS_X_BYTES + 2048 + 16;
constexpr size_t XCD_BAR_BYTES = 3456 * 4;

constexpr size_t N_WIN = 2560ull * 1024, N_WSQ = 1024ull * 1024, N_WQKV = 1536ull * 1024, N_WFF = 4096ull * 1024;
constexpr size_t OFF_WIN = 0;
constexpr size_t OFF_WOUT = OFF_WIN + N_WIN * 2;
constexpr size_t OFF_WQKV = OFF_WOUT + N_WSQ * 2;
constexpr size_t OFF_WO = OFF_WQKV + N_WQKV * 2;
constexpr size_t OFF_WUP = OFF_WO + N_WSQ * 2;
constexpr size_t OFF_WDN = OFF_WUP + 2 * N_WFF * 2;
constexpr size_t OFF_H3 = OFF_WDN + 2 * N_WFF * 2;
constexpr size_t OFF_HN = OFF_H3 + 12288ull * 64 * 4;
constexpr size_t OFF_BIG = OFF_HN + (size_t)NTOK * 1024 * 2;
constexpr size_t OFF_SPEC = OFF_BIG + (size_t)NTOK * 1536 * 2;
constexpr size_t OFF_ZST = OFF_BIG + 268435456ull;
constexpr size_t OFF_BAR = OFF_ZST + 256ull * 8192 * 8;
constexpr size_t WS_END = OFF_BAR + XCD_BAR_BYTES;

struct Params {
    const float* in[28];
    float* out;
    unsigned char* ws;
    int ph_lo, ph_hi;
};

__device__ __forceinline__ float bf2f(bf16_t b) { return __uint_as_float(((unsigned)b) << 16); }
__device__ __forceinline__ bf16_t f2bf(float f) { unsigned u = __float_as_uint(f); u += 0x7FFFu + ((u >> 16) & 1u); return (bf16_t)(u >> 16); }
__device__ __forceinline__ unsigned pk2(float lo, float hi) { return (unsigned)f2bf(lo) | ((unsigned)f2bf(hi) << 16); }
__device__ __forceinline__ float wave_sum(float v) {
#pragma unroll
    for (int o = 32; o >= 1; o >>= 1) v += __shfl_xor(v, o, 64);
    return v;
}
__device__ __forceinline__ void seq_of_row(int row, int& L, int& row0) {
    if (row < 32768) { L = 8192; row0 = row & ~8191; } else { L = 4096; row0 = 32768 + ((row - 32768) & ~4095); }
}

namespace pg8 {
constexpr int BM = 256, BK = 64, HALF = 128, HTB = HALF * BK * 2, STAGE_BYTES = 8 * HTB, NXCD = 8, WGM = 8;
__device__ __forceinline__ int lds_byte(int r, int c) { const int st = (r >> 4) * 2 + (c >> 5), rr = r & 15, cc = c & 31, ob = rr * 64 + cc * 2; return st * 1024 + (ob ^ (((ob >> 9) & 1) << 5)); }
__device__ __forceinline__ void stage_rc(int b, int& R, int& C) { const int st = b / 1024, sb = b % 1024, swz = sb ^ (((sb >> 9) & 1) << 5); R = (st >> 1) * 16 + swz / 64; C = (st & 1) * 32 + (swz % 64) / 2; }
__device__ __forceinline__ int perm32(int rho) { const int n = rho >> 4, i = rho & 15; return 8 * (i >> 2) + 4 * n + (i & 3); }
struct Unit { int pm, pn; };
struct Gemm { const bf16_t* A; const bf16_t* Bt; int M, N, K; };
struct StaticOrder {
    int nM, nN, nwg, G, c;
    __device__ __forceinline__ void init(int M, int N, int G_, int c_) { nM = M / BM; nN = N / BM; nwg = nM * nN; G = G_; c = c_; }
    __device__ __forceinline__ bool next(int i, Unit& u) const {
        const long L = (long)i * G + c; if (L >= nwg) return false;
        int wgid = (int)L; { const int q = nwg / NXCD, r = nwg % NXCD, xcd = wgid % NXCD, off = wgid / NXCD; wgid = (xcd < r ? xcd * (q + 1) : r * (q + 1) + (xcd - r) * q) + off; }
        const int nig = WGM * nN, gid = wgid / nig, fm = gid * WGM, gsz = (nM - fm) < WGM ? (nM - fm) : WGM;
        u.pm = fm + ((wgid % nig) % gsz); u.pn = (wgid % nig) / gsz; return true;
    }
};

struct EpiBf {
    static constexpr bool PERM = true;
    int mode; bf16_t* O; int ldc; bf16_t* O2;
    __device__ __forceinline__ void operator()(const f32x4 (&acc)[2][2][4][2], const Unit& u, int wr, int wc, int fr, int fq) const {
        const int row0 = u.pm * BM + wr * 64 + fr, colt = u.pn * BM;
#pragma unroll
        for (int ai = 0; ai < 2; ++ai)
#pragma unroll
            for (int m = 0; m < 4; ++m) {
                const size_t row = (size_t)(row0 + ai * HALF + m * 16);
#pragma unroll
                for (int bj = 0; bj < 2; ++bj) {
                    const int c0 = colt + bj * HALF + wc * 32 + 8 * fq;
                    f32x4 v0 = acc[ai][bj][m][0], v1 = acc[ai][bj][m][1];
                    if (mode == 2) {
                        if (colt < 1024) {
                            float h[4];
#pragma unroll
                            for (int i = 0; i < 4; ++i) h[i] = v0[i] / (1.0f + __expf(-v1[i]));
                            u32x2 o; o.x = pk2(h[0], h[1]); o.y = pk2(h[2], h[3]);
                            *(u32x2*)(O + row * 512 + (c0 >> 1)) = o;
                        } else {
                            u32x4 o; o.x = pk2(v0[0], v0[1]); o.y = pk2(v0[2], v0[3]); o.z = pk2(v1[0], v1[1]); o.w = pk2(v1[2], v1[3]);
                            *(u32x4*)(O2 + row * 1536 + (c0 - 1024)) = o;
                        }
                    } else {
                        if (mode == 1) {
#pragma unroll
                            for (int i = 0; i < 4; ++i) { float a = fmaxf(v0[i], 0.f), b = fmaxf(v1[i], 0.f); v0[i] = a * a; v1[i] = b * b; }
                        }
                        u32x4 o; o.x = pk2(v0[0], v0[1]); o.y = pk2(v0[2], v0[3]); o.z = pk2(v1[0], v1[1]); o.w = pk2(v1[2], v1[3]);
                        *(u32x4*)(O + row * ldc + c0) = o;
                    }
                }
            }
    }
};
struct EpiRes {
    static constexpr bool PERM = false;
    const float* res0; const float* res1; float* out; int row_off;
    __device__ __forceinline__ void operator()(const f32x4 (&acc)[2][2][4][2], const Unit& u, int wr, int wc, int fr, int fq) const {
        const int row0 = row_off + u.pm * BM + wr * 64 + fr, col0 = u.pn * BM + wc * 32 + 4 * fq;
#pragma unroll
        for (int ai = 0; ai < 2; ++ai)
#pragma unroll
            for (int m = 0; m < 4; ++m) {
                const int row = row0 + ai * HALF + m * 16;
                const float* rp = (row < 32768) ? res0 + (size_t)row * 1024 : res1 + (size_t)(row - 32768) * 1024;
                float* op = out + (size_t)row * 1024;
#pragma unroll
                for (int bj = 0; bj < 2; ++bj)
#pragma unroll
                    for (int n = 0; n < 2; ++n) { const int c = col0 + bj * HALF + n * 16; *(f32x4*)(op + c) = *(const f32x4*)(rp + c) + acc[ai][bj][m][n]; }
            }
    }
};

template <class Epi>
__device__ __forceinline__ void gemm_phase(LAS unsigned char* lds, const Gemm g, const StaticOrder& S, const Epi& E) {
    int tid = threadIdx.x; LAUNDER(tid);
    const int wid = __builtin_amdgcn_readfirstlane(tid >> 6), lane = tid & 63, wr = wid >> 2, wc = wid & 3, fr = lane & 15, fq = lane >> 4;
    const int K = g.K, nt = K / BK;
    unsigned voffA[2], voffB[2];
#pragma unroll
    for (int i = 0; i < 2; ++i) { int R, C; stage_rc(tid * 16 + i * 8192, R, C); const int Rb = Epi::PERM ? ((R & ~31) + perm32(R & 31)) : R;
        voffA[i] = (unsigned)(R * K + C) * 2u; voffB[i] = (unsigned)(Rb * K + C) * 2u; }
    const size_t kstep = (size_t)(BK * 2);
    const size_t hstep = (size_t)HALF * K * 2;
    const size_t tstep = 2 * hstep;
    const unsigned ldsw = (unsigned)wid * 1024u;
    const int aoff = lds_byte(wr * 64 + fr, fq * 8), boff = lds_byte(wc * 32 + fr, fq * 8);
#define PG8_SA(b, h) (((b) * 2 + (h)) * HTB)
#define PG8_SB(b, h) ((4 + (b) * 2 + (h)) * HTB)
#define PG8_STAGE(bufoff, gbase, voff) do { _Pragma("unroll") for (int _i = 0; _i < 2; ++_i) \
        __builtin_amdgcn_global_load_lds((const unsigned*)((const char*)(gbase) + (voff)[_i]), (LAS unsigned*)(lds + (bufoff) + ldsw + _i * 8192), 16, 0, 0); } while (0)
#define PG8_LDA(dst, b, h) do { _Pragma("unroll") for (int m = 0; m < 4; ++m) _Pragma("unroll") for (int k = 0; k < 2; ++k) dst[m][k] = *(const LAS bf16x8*)(lds + PG8_SA(b, h) + aoff + m * 2048 + k * 1024); } while (0)
#define PG8_LDB(dst, b, h) do { _Pragma("unroll") for (int n = 0; n < 2; ++n) _Pragma("unroll") for (int k = 0; k < 2; ++k) dst[n][k] = *(const LAS bf16x8*)(lds + PG8_SB(b, h) + boff + n * 2048 + k * 1024); } while (0)
#define PG8_MMA(ai, bj, At, Bt) do { __builtin_amdgcn_s_setprio(1); _Pragma("unroll") for (int m = 0; m < 4; ++m) _Pragma("unroll") for (int n = 0; n < 2; ++n) _Pragma("unroll") for (int k = 0; k < 2; ++k) \
        acc[ai][bj][m][n] = __builtin_amdgcn_mfma_f32_16x16x32_bf16(Bt[n][k], At[m][k], acc[ai][bj][m][n], 0, 0, 0); __builtin_amdgcn_s_setprio(0); } while (0)
#define PG8_WAIT_V(n) asm volatile("s_waitcnt vmcnt(" #n ")" ::: "memory")
#define PG8_WAIT_L(n) asm volatile("s_waitcnt lgkmcnt(" #n ")" ::: "memory")
#define PG8_BAR __builtin_amdgcn_s_barrier()
#define PG8_SCHED __builtin_amdgcn_sched_barrier(0)
    Unit cur, nxt; int ui = 0;
    if (!S.next(0, cur)) return;
    f32x4 acc[2][2][4][2];
#pragma unroll
    for (int a = 0; a < 2; ++a)
#pragma unroll
        for (int b = 0; b < 2; ++b)
#pragma unroll
            for (int m = 0; m < 4; ++m)
#pragma unroll
                for (int n = 0; n < 2; ++n) acc[a][b][m][n] = (f32x4){0.f, 0.f, 0.f, 0.f};
    bf16x8 At[4][2], B0[2][2], B1[2][2];
    const char* cA = (const char*)g.A + (size_t)cur.pm * tstep; const char* cB = (const char*)g.Bt + (size_t)cur.pn * tstep;
    PG8_STAGE(PG8_SB(0, 0), cB, voffB); PG8_STAGE(PG8_SA(0, 0), cA, voffA); PG8_STAGE(PG8_SB(0, 1), cB + hstep, voffB); PG8_STAGE(PG8_SA(0, 1), cA + hstep, voffA);
    if (wr == 1) PG8_BAR;
    PG8_WAIT_V(4); PG8_BAR;
    PG8_STAGE(PG8_SB(1, 0), cB + kstep, voffB); PG8_STAGE(PG8_SA(1, 0), cA + kstep, voffA); PG8_STAGE(PG8_SB(1, 1), cB + hstep + kstep, voffB);
    PG8_WAIT_V(6); PG8_BAR;
    for (;;) {
        const bool has_next = S.next(ui + 1, nxt);
        const char* nA = has_next ? (const char*)g.A + (size_t)nxt.pm * tstep : cA; const char* nB = has_next ? (const char*)g.Bt + (size_t)nxt.pn * tstep : cB;
        for (int t = 0; t < nt; t += 2) {
            const bool last = (t == nt - 2);
            const char* a1 = cA + (size_t)(t + 1) * kstep;
            const char* a2 = last ? nA : cA + (size_t)(t + 2) * kstep; const char* b2 = last ? nB : cB + (size_t)(t + 2) * kstep;
            const char* a3 = a2 + kstep; const char* b3 = b2 + kstep;
            PG8_LDB(B0, 0, 0); PG8_SCHED; PG8_LDA(At, 0, 0); PG8_STAGE(PG8_SA(1, 1), a1 + hstep, voffA);
            PG8_WAIT_L(8); PG8_BAR; PG8_WAIT_L(0); PG8_MMA(0, 0, At, B0); PG8_BAR; PG8_SCHED;
            PG8_LDB(B1, 0, 1); PG8_STAGE(PG8_SB(0, 0), b2, voffB);
            PG8_BAR; PG8_WAIT_L(0); PG8_MMA(0, 1, At, B1); PG8_BAR;
            PG8_LDA(At, 0, 1); PG8_STAGE(PG8_SA(0, 0), a2, voffA);
            PG8_BAR; PG8_WAIT_L(0); PG8_MMA(1, 0, At, B0); PG8_BAR; PG8_SCHED;
            PG8_STAGE(PG8_SB(0, 1), b2 + hstep, voffB);
            PG8_WAIT_V(6); PG8_BAR; PG8_MMA(1, 1, At, B1); PG8_BAR;
            PG8_LDB(B0, 1, 0); PG8_SCHED; PG8_LDA(At, 1, 0); PG8_STAGE(PG8_SA(0, 1), a2 + hstep, voffA);
            PG8_WAIT_L(8); PG8_BAR; PG8_WAIT_L(0); PG8_MMA(0, 0, At, B0); PG8_BAR; PG8_SCHED;
            PG8_LDB(B1, 1, 1); PG8_STAGE(PG8_SB(1, 0), b3, voffB);
            PG8_BAR; PG8_WAIT_L(0); PG8_MMA(0, 1, At, B1); PG8_BAR;
            PG8_LDA(At, 1, 1); PG8_STAGE(PG8_SA(1, 0), a3, voffA);
            PG8_BAR; PG8_WAIT_L(0); PG8_MMA(1, 0, At, B0); PG8_BAR; PG8_SCHED;
            PG8_STAGE(PG8_SB(1, 1), b3 + hstep, voffB);
            PG8_WAIT_V(6); PG8_BAR; PG8_MMA(1, 1, At, B1); PG8_BAR;
        }
        E(acc, cur, wr, wc, fr, fq);
        if (!has_next) break;
#pragma unroll
        for (int a = 0; a < 2; ++a)
#pragma unroll
            for (int b = 0; b < 2; ++b)
#pragma unroll
                for (int m = 0; m < 4; ++m)
#pragma unroll
                    for (int n = 0; n < 2; ++n) acc[a][b][m][n] = (f32x4){0.f, 0.f, 0.f, 0.f};
        cur = nxt; cA = nA; cB = nB; ++ui;
    }
    PG8_WAIT_V(0);
    if (wr == 0) PG8_BAR;
    PG8_BAR;
#undef PG8_SA
#undef PG8_SB
#undef PG8_STAGE
#undef PG8_LDA
#undef PG8_LDB
#undef PG8_MMA
#undef PG8_WAIT_V
#undef PG8_WAIT_L
#undef PG8_BAR
#undef PG8_SCHED
}
}

typedef float cf __attribute__((ext_vector_type(2)));
#define CF(a, b) ((cf){(a), (b)})
__host__ __device__ __forceinline__ cf cmul(cf a, cf b) { return CF(a.x * b.x - a.y * b.y, a.x * b.y + a.y * b.x); }
__host__ __device__ __forceinline__ cf cmulc(cf a, cf b) { return CF(a.x * b.x + a.y * b.y, a.y * b.x - a.x * b.y); }
__host__ __device__ __forceinline__ cf cadd(cf a, cf b) { return CF(a.x + b.x, a.y + b.y); }
__host__ __device__ __forceinline__ cf csub(cf a, cf b) { return CF(a.x - b.x, a.y - b.y); }
__host__ __device__ __forceinline__ int phys(int a) { return a + (a >> 4); }
__host__ __device__ __forceinline__ cf w16(int e) {
    switch (e) {
        case 0: return CF(1.0f, 0.0f);
        case 1: return CF(0.9238795325112867f, -0.3826834323650898f);
        case 2: return CF(0.7071067811865476f, -0.7071067811865476f);
        case 3: return CF(0.3826834323650898f, -0.9238795325112867f);
        case 4: return CF(0.0f, -1.0f);
        case 5: return CF(-0.3826834323650898f, -0.9238795325112867f);
        case 6: return CF(-0.7071067811865476f, -0.7071067811865476f);
        default: return CF(-0.9238795325112867f, -0.3826834323650898f);
    }
}
template <int R> __host__ __device__ __forceinline__ constexpr int bitrev_r(int k) {
    return (R == 2) ? k : (R == 4) ? (((k & 1) << 1) | (k >> 1)) : (((k & 1) << 3) | ((k & 2) << 1) | ((k & 4) >> 1) | ((k & 8) >> 3));
}
template <int R> struct LogR { static constexpr int v = (R == 16) ? 4 : (R == 4) ? 2 : 1; };
__host__ __device__ __forceinline__ cf twiddle_base(int n, int M) {
    float s, c; const float x = 2.0f * (float)n / (float)M;
#if defined(__HIP_DEVICE_COMPILE__)
    s = sinpif(x); c = cospif(x);
#else
    s = (float)sin(3.14159265358979323846 * (double)x); c = (float)cos(3.14159265358979323846 * (double)x);
#endif
    return CF(c, -s);
}
template <int R> __host__ __device__ __forceinline__ void make_tw(cf (&tw)[R], int n, int M) {
    tw[0] = CF(1.f, 0.f);
    if (R > 1) tw[1] = twiddle_base(n, M);
#pragma unroll
    for (int k = 2; k < R; ++k) tw[k] = (k & 1) ? cmul(tw[k - 1], tw[1]) : cmul(tw[k / 2], tw[k / 2]);
}

template <int R, typename XP> __host__ __device__ __forceinline__ void fwd_pass(XP X, int N, int M, int tid) {
    const int m = M / R, ps = (m >= 16) ? m + (m >> 4) : m;
    LAUNDER(tid);
#pragma unroll 1
    for (int g = tid; g < N / R; g += NT) {
        const int n = g % m, B = (g / m) * M, pb = phys(B + n);
        cf v[R];
#pragma unroll
        for (int j = 0; j < R; ++j) v[j] = X[pb + j * ps];
#pragma unroll
        for (int st = 0; st < LogR<R>::v; ++st) {
            const int h = (R / 2) >> st;
#pragma unroll
            for (int j = 0; j < R; ++j) {
                if ((j & h) == 0) {
                    const cf a = v[j], b = v[j + h];
                    v[j] = cadd(a, b);
                    const int e = (j % h) * (16 / (2 * h));
                    v[j + h] = cmul(csub(a, b), w16(e));
                }
            }
        }
        cf tw[R]; make_tw<R>(tw, n, M);
#pragma unroll
        for (int k = 0; k < R; ++k) X[pb + k * ps] = cmul(v[bitrev_r<R>(k)], tw[k]);
    }
}
template <int R, typename XP> __host__ __device__ __forceinline__ void inv_pass(XP X, int N, int M, int tid) {
    const int m = M / R, ps = (m >= 16) ? m + (m >> 4) : m;
    LAUNDER(tid);
#pragma unroll 1
    for (int g = tid; g < N / R; g += NT) {
        const int n = g % m, B = (g / m) * M, pb = phys(B + n);
        cf tw[R]; make_tw<R>(tw, n, M);
        cf v[R];
#pragma unroll
        for (int k = 0; k < R; ++k) v[bitrev_r<R>(k)] = cmulc(X[pb + k * ps], tw[k]);
#pragma unroll
        for (int st = 0; st < LogR<R>::v; ++st) {
            const int h = 1 << st;
#pragma unroll
            for (int j = 0; j < R; ++j) {
                if ((j & h) == 0) {
                    const int e = (j % h) * (16 / (2 * h));
                    const cf a = v[j], b = cmulc(v[j + h], w16(e));
                    v[j] = cadd(a, b); v[j + h] = csub(a, b);
                }
            }
        }
#pragma unroll
        for (int j = 0; j < R; ++j) X[pb + j * ps] = v[j];
    }
}
#if !defined(FFT_HOST_TEST)
#define FFT_SYNC() __syncthreads()
template <int N> __device__ __forceinline__ void fft_fwd(LAS cf* X, int tid) {
    fwd_pass<N / 4096>(X, N, N, tid); FFT_SYNC();
    fwd_pass<16>(X, N, 4096, tid); FFT_SYNC();
    fwd_pass<16>(X, N, 256, tid); FFT_SYNC();
    fwd_pass<16>(X, N, 16, tid); FFT_SYNC();
}
template <int N> __device__ __forceinline__ void fft_inv(LAS cf* X, int tid) {
    inv_pass<16>(X, N, 16, tid); FFT_SYNC();
    inv_pass<16>(X, N, 256, tid); FFT_SYNC();
    inv_pass<16>(X, N, 4096, tid); FFT_SYNC();
    inv_pass<N / 4096>(X, N, N, tid); FFT_SYNC();
}
#endif

#if !defined(FFT_HOST_TEST)
__device__ __forceinline__ void phase_rmsnorm(const float* src0, const float* src1, const float* g, bf16_t* dst_bf, float* dst_f) {
    int tid = threadIdx.x; LAUNDER(tid);
    const int lane = tid & 63, wv = tid >> 6;
    const int gw = blockIdx.x * 8 + wv, nw = gridDim.x * 8;
    f32x4 gv[4];
#pragma unroll
    for (int i = 0; i < 4; ++i) gv[i] = *(const f32x4*)(g + 4 * (lane + 64 * i));
    for (int row = gw; row < NTOK; row += nw) {
        const float* src = (row < 32768) ? src0 + (size_t)row * 1024 : src1 + (size_t)(row - 32768) * 1024;
        f32x4 v[4]; float ss = 0.f;
#pragma unroll
        for (int i = 0; i < 4; ++i) { v[i] = *(const f32x4*)(src + 4 * (lane + 64 * i)); ss += v[i][0] * v[i][0] + v[i][1] * v[i][1] + v[i][2] * v[i][2] + v[i][3] * v[i][3]; }
        ss = wave_sum(ss);
        const float rstd = rsqrtf(ss * (1.0f / 1024.0f) + 1e-5f);
#pragma unroll
        for (int i = 0; i < 4; ++i) {
            f32x4 o = v[i] * rstd * gv[i];
            if (dst_bf) { u32x2 p; p.x = pk2(o[0], o[1]); p.y = pk2(o[2], o[3]); *(u32x2*)(dst_bf + (size_t)row * 1024 + 4 * (lane + 64 * i)) = p; }
            else *(f32x4*)(dst_f + (size_t)row * 1024 + 4 * (lane + 64 * i)) = o;
        }
    }
}

__device__ __forceinline__ void phase_weights(const Params& p, LAS float* T) {
    int tid = threadIdx.x; LAUNDER(tid);
    for (int mi = 0; mi < 8; ++mi) {
        const float* src; bf16_t* dst; int K, N; bool perm = false;
        switch (mi) {
            case 0: src = p.in[5]; dst = (bf16_t*)(p.ws + OFF_WIN); K = 1024; N = 2560; perm = true; break;
            case 1: src = p.in[6]; dst = (bf16_t*)(p.ws + OFF_WOUT); K = 1024; N = 1024; break;
            case 2: src = p.in[23]; dst = (bf16_t*)(p.ws + OFF_WQKV); K = 1024; N = 1536; break;
            case 3: src = p.in[25]; dst = (bf16_t*)(p.ws + OFF_WO); K = 1024; N = 1024; break;
            case 4: src = p.in[26]; dst = (bf16_t*)(p.ws + OFF_WUP); K = 1024; N = 4096; break;
            case 5: src = p.in[26] + N_WFF; dst = (bf16_t*)(p.ws + OFF_WUP) + N_WFF; K = 1024; N = 4096; break;
            case 6: src = p.in[27]; dst = (bf16_t*)(p.ws + OFF_WDN); K = 4096; N = 1024; break;
            default: src = p.in[27] + N_WFF; dst = (bf16_t*)(p.ws + OFF_WDN) + N_WFF; K = 4096; N = 1024; break;
        }
        const int tk = K / 64, tn = N / 64;
        for (int it = blockIdx.x; it < tk * tn; it += gridDim.x) {
            const int k0 = (it / tn) * 64, n0 = (it % tn) * 64;
#pragma unroll
            for (int i = 0; i < 8; ++i) { const int idx = tid + NT * i, r = idx >> 6, c = idx & 63; T[r * 65 + c] = src[(size_t)(k0 + r) * N + n0 + c]; }
            __syncthreads();
#pragma unroll
            for (int i = 0; i < 8; ++i) {
                const int idx = tid + NT * i, nl = idx >> 6, kl = idx & 63; int n = n0 + nl;
                if (perm && n < 1024) { const int nn = n & 511, q = nn >> 2, e = nn & 3; n = 8 * q + e + ((n >= 512) ? 4 : 0); }
                dst[(size_t)n * K + k0 + kl] = f2bf(T[kl * 65 + nl]);
            }
            __syncthreads();
        }
    }
}

__device__ __forceinline__ void phase_filter_hidden(const Params& p) {
    int tid = threadIdx.x; LAUNDER(tid);
    const int lane = tid & 63, wv = tid >> 6;
    const int gw = blockIdx.x * 8 + wv, nw = gridDim.x * 8;
    const float* w1 = p.in[13]; const float* b1 = p.in[14]; const float* w2 = p.in[15]; const float* b2 = p.in[16];
    const float* w3 = p.in[17]; const float* b3 = p.in[18]; const float* fr = p.in[20];
    float* H3 = (float*)(p.ws + OFF_H3);
    for (int pg = gw; pg < 12288; pg += nw) {
        const int L = (pg < 8192) ? 8192 : 4096, pos = (pg < 8192) ? pg : pg - 8192;
        const float t = (float)pos / (float)(L - 1);
        const float w = 6.283185307179586f * (float)pos / (float)L;
        float z = 0.f;
        if (lane == 0) z = t;
        else if (lane <= 32) {
            const int bi = (lane - 1) & 15;
            const float f = 1e-4f + (float)bi * ((15.0f - 1e-4f) / 15.0f);
            const float a = w * f;
            z = (lane <= 16) ? cosf(a) : -sinf(a);
        }
        float a1 = b1[lane];
        for (int i = 0; i < 33; ++i) a1 += __shfl(z, i, 64) * w1[i * 64 + lane];
        const float h1 = sinf(fr[lane] * a1);
        float a2 = b2[lane];
        for (int i = 0; i < 64; ++i) a2 += __shfl(h1, i, 64) * w2[i * 64 + lane];
        const float h2 = sinf(fr[64 + lane] * a2);
        float a3 = b3[lane];
        for (int i = 0; i < 64; ++i) a3 += __shfl(h2, i, 64) * w3[i * 64 + lane];
        const float h3 = sinf(fr[128 + lane] * a3);
        H3[(size_t)pg * 64 + lane] = h3;
    }
}

__device__ __forceinline__ void phase_conformer(const Params& p, LAS unsigned char* lds) {
    int tid = threadIdx.x; LAUNDER(tid);
    const int lane = tid & 63, wv = tid >> 6;
    const bf16_t* HCV = (const bf16_t*)p.out;
    bf16_t* YCAT = (bf16_t*)(p.ws + OFF_HN);
    LAS bf16_t* hb = (LAS bf16_t*)lds;
    LAS float* ob = (LAS float*)(lds + 62 * 512 * 2);
    const float* dw = p.in[7]; const float* db = p.in[8]; const float* lg = p.in[9]; const float* lb = p.in[10];
    float w[31];
#pragma unroll
    for (int k = 0; k < 31; ++k) w[k] = dw[k * 512 + tid];
    const float bias = db[tid];
    float gg[8], bb[8];
#pragma unroll
    for (int i = 0; i < 8; ++i) { gg[i] = lg[lane * 8 + i]; bb[i] = lb[lane * 8 + i]; }
    for (int it = blockIdx.x; it < NTOK / 32; it += gridDim.x) {
        const int rowbase = it * 32; int L, row0; seq_of_row(rowbase, L, row0);
        const int t0 = rowbase - row0;
        for (int idx = tid; idx < 62 * 64; idx += NT) {
            const int r = idx >> 6, c8 = idx & 63, t = t0 - 15 + r;
            u32x4 v = (u32x4){0u, 0u, 0u, 0u};
            if (t >= 0 && t < L) v = *(const u32x4*)(HCV + (size_t)(row0 + t) * 512 + c8 * 8);
            *(LAS u32x4*)(hb + r * 512 + c8 * 8) = v;
        }
        __syncthreads();
        float acc[32];
#pragma unroll
        for (int i = 0; i < 32; ++i) acc[i] = bias;
#pragma unroll
        for (int r = 0; r < 62; ++r) {
            const float val = bf2f(hb[r * 512 + tid]);
#pragma unroll
            for (int tt = 0; tt < 32; ++tt) { if (r - tt >= 0 && r - tt < 31) acc[tt] += w[r - tt] * val; }
        }
#pragma unroll
        for (int tt = 0; tt < 32; ++tt) ob[tt * 512 + tid] = acc[tt];
        __syncthreads();
#pragma unroll
        for (int i = 0; i < 4; ++i) {
            const int tt = wv + 8 * i;
            f32x4 v0 = *(const LAS f32x4*)(ob + tt * 512 + lane * 8), v1 = *(const LAS f32x4*)(ob + tt * 512 + lane * 8 + 4);
            float s = v0[0] + v0[1] + v0[2] + v0[3] + v1[0] + v1[1] + v1[2] + v1[3];
            s = wave_sum(s); const float mu = s * (1.0f / 512.0f);
            float x[8]; float q = 0.f;
#pragma unroll
            for (int j = 0; j < 4; ++j) { x[j] = v0[j] - mu; x[4 + j] = v1[j] - mu; }
#pragma unroll
            for (int j = 0; j < 8; ++j) q += x[j] * x[j];
            q = wave_sum(q); const float rstd = rsqrtf(q * (1.0f / 512.0f) + 1e-5f);
            float y[8];
#pragma unroll
            for (int j = 0; j < 8; ++j) { const float a = x[j] * rstd * gg[j] + bb[j]; y[j] = a / (1.0f + __expf(-a)); }
            u32x4 o; o.x = pk2(y[0], y[1]); o.y = pk2(y[2], y[3]); o.z = pk2(y[4], y[5]); o.w = pk2(y[6], y[7]);
            *(u32x4*)(YCAT + (size_t)(rowbase + tt) * 1024 + lane * 8) = o;
        }
        __syncthreads();
    }
}

__device__ __forceinline__ void phase_shortconv_T(const Params& p, LAS float* U) {
    int tid = threadIdx.x; LAUNDER(tid);
    const bf16_t* UHY = (const bf16_t*)p.out + (size_t)NTOK * 512;
    bf16_t* XT = (bf16_t*)(p.ws + OFF_BIG);
    const float* sw = p.in[11]; const float* sb = p.in[12];
    for (int it = blockIdx.x; it < (NTOK / 64) * 12; it += gridDim.x) {
        const int tile = it / 12, cht = it % 12, rowbase = tile * 64; int L, row0; seq_of_row(rowbase, L, row0);
        const int t0 = rowbase - row0;
        for (int idx = tid; idx < 66 * 16; idx += NT) {
            const int r = idx >> 4, c8 = idx & 15, t = t0 - 1 + r;
            u32x4 v = (u32x4){0u, 0u, 0u, 0u};
            if (t >= 0 && t < L) v = *(const u32x4*)(UHY + (size_t)(row0 + t) * 1536 + cht * 128 + c8 * 8);
            LAS float* d = U + r * 129 + c8 * 8;
            d[0] = __uint_as_float(v.x << 16); d[1] = __uint_as_float(v.x & 0xffff0000u);
            d[2] = __uint_as_float(v.y << 16); d[3] = __uint_as_float(v.y & 0xffff0000u);
            d[4] = __uint_as_float(v.z << 16); d[5] = __uint_as_float(v.z & 0xffff0000u);
            d[6] = __uint_as_float(v.w << 16); d[7] = __uint_as_float(v.w & 0xffff0000u);
        }
        __syncthreads();
        for (int idx = tid; idx < 128 * 64; idx += NT) {
            const int chl = idx >> 6, tl = idx & 63, ch = cht * 128 + chl;
            const float val = sb[ch] + sw[ch] * U[tl * 129 + chl] + sw[1536 + ch] * U[(tl + 1) * 129 + chl] + sw[3072 + ch] * U[(tl + 2) * 129 + chl];
            XT[(size_t)row0 * 1536 + (size_t)ch * L + t0 + tl] = f2bf(val);
        }
        __syncthreads();
    }
}

__device__ __forceinline__ void phase_zT(const Params& p, LAS float* U) {
    int tid = threadIdx.x; LAUNDER(tid);
    const bf16_t* XT = (const bf16_t*)(p.ws + OFF_BIG);
    bf16_t* YCAT = (bf16_t*)(p.ws + OFF_HN);
    for (int it = blockIdx.x; it < (NTOK / 64) * 8; it += gridDim.x) {
        const int tile = it / 8, cht = it % 8, rowbase = tile * 64; int L, row0; seq_of_row(rowbase, L, row0);
        const int t0 = rowbase - row0;
#pragma unroll
        for (int i = 0; i < 8; ++i) {
            const int idx = tid + NT * i, chl = idx >> 6, tl = idx & 63;
            U[chl * 65 + tl] = bf2f(XT[(size_t)row0 * 1536 + (size_t)(1024 + cht * 64 + chl) * L + t0 + tl]);
        }
        __syncthreads();
#pragma unroll
        for (int i = 0; i < 8; ++i) {
            const int idx = tid + NT * i, tl = idx >> 6, chl = idx & 63;
            YCAT[(size_t)(rowbase + tl) * 1024 + 512 + cht * 64 + chl] = f2bf(U[chl * 65 + tl]);
        }
        __syncthreads();
    }
}

__device__ __forceinline__ float block_sum(float v, LAS float* red, int tid) {
    v = wave_sum(v);
    __syncthreads();
    if ((tid & 63) == 0) red[tid >> 6] = v;
    __syncthreads();
    float s = 0.f;
#pragma unroll
    for (int i = 0; i < 8; ++i) s += red[i];
    return s;
}
template <int L> __device__ __forceinline__ void hyena_item(const Params& p, LAS unsigned char* lds, int c) {
    constexpr int N = 2 * L, PT = L / NT;
    constexpr int NSEQ = (L == 8192) ? 4 : 8, SEQ0ROW = (L == 8192) ? 0 : 32768;
    int tid = threadIdx.x; LAUNDER(tid);
    LAS cf* X = (LAS cf*)lds;
    LAS float* w4s = (LAS float*)(lds + LDS_X_BYTES);
    LAS float* red = w4s + 256;
    const float* H3 = (const float*)(p.ws + OFF_H3) + ((L == 8192) ? 0 : 8192 * 64);
    const float* w4 = p.in[19]; const float* decay = p.in[21]; const float* skip = p.in[22];
    cf* SPEC = (cf*)(p.ws + OFF_SPEC) + (size_t)blockIdx.x * 2 * 16384;
    bf16_t* XT = (bf16_t*)(p.ws + OFF_BIG);
    cf* ZST = (cf*)(p.ws + OFF_ZST) + (size_t)blockIdx.x * 8192;
    __syncthreads();
    if (tid < 256) { const int col = (tid >> 6) * 512 + c, j = tid & 63; w4s[tid] = w4[j * 2048 + col]; }
    __syncthreads();
    float dec[4];
#pragma unroll
    for (int q = 0; q < 4; ++q) dec[q] = fabsf(decay[q * 512 + c]);
    float ss0 = 0.f, ss1 = 0.f;
#pragma unroll 1
    for (int i = 0; i < PT; ++i) {
        const int t = tid + NT * i;
        float a0 = 0.f, a1 = 0.f, a2 = 0.f, a3 = 0.f;
        const f32x4* hr = (const f32x4*)(H3 + (size_t)t * 64);
#pragma unroll 4
        for (int j4 = 0; j4 < 16; ++j4) {
            const f32x4 h = hr[j4];
#pragma unroll
            for (int e = 0; e < 4; ++e) { const int j = j4 * 4 + e; a0 += h[e] * w4s[j]; a1 += h[e] * w4s[64 + j]; a2 += h[e] * w4s[128 + j]; a3 += h[e] * w4s[192 + j]; }
        }
        const float tn = (float)t / (float)(L - 1);
        a0 *= __expf(-tn * dec[0]); a1 *= __expf(-tn * dec[1]); a2 *= __expf(-tn * dec[2]); a3 *= __expf(-tn * dec[3]);
        ss0 += a0 * a0 + ((t > 0) ? a1 * a1 : 0.f);
        ss1 += a2 * a2 + ((t > 0) ? a3 * a3 : 0.f);
        X[phys(t)] = CF(a0, 0.f);
        if (t > 0) X[phys(N - t)] = CF(a1, 0.f); else X[phys(L)] = CF(0.f, 0.f);
        SPEC[16384 + t] = CF(a2, a3);
    }
    ss0 = block_sum(ss0, red, tid);
    ss1 = block_sum(ss1, red, tid);
    const float sc0 = rsqrtf(ss0 + 1e-6f) * (1.0f / (float)N), sc1 = rsqrtf(ss1 + 1e-6f) * (1.0f / (float)N);
    __syncthreads();
    fft_fwd<N>(X, tid);
    for (int a = tid; a < N; a += NT) { const cf v = X[phys(a)]; SPEC[a] = CF(v.x * sc0, v.y * sc0); }
    __syncthreads();
#pragma unroll 1
    for (int i = 0; i < PT; ++i) {
        const int t = tid + NT * i;
        const cf fb = SPEC[16384 + t];
        X[phys(t)] = CF(fb.x, 0.f);
        if (t > 0) X[phys(N - t)] = CF(fb.y, 0.f); else X[phys(L)] = CF(0.f, 0.f);
    }
    __syncthreads();
    fft_fwd<N>(X, tid);
    for (int a = tid; a < N; a += NT) { const cf v = X[phys(a)]; SPEC[16384 + a] = CF(v.x * sc1, v.y * sc1); }
    __threadfence_block();
    __syncthreads();
    const float sk0 = skip[c], sk1 = skip[512 + c];
    for (int pr = 0; pr < NSEQ / 2; ++pr) {
        const size_t base0 = (size_t)(SEQ0ROW + (2 * pr) * L) * 1536, base1 = (size_t)(SEQ0ROW + (2 * pr + 1) * L) * 1536;
        const bf16_t* x1a = XT + base0 + (size_t)c * L;            const bf16_t* x1b = XT + base1 + (size_t)c * L;
        const bf16_t* x2a = XT + base0 + (size_t)(512 + c) * L;    const bf16_t* x2b = XT + base1 + (size_t)(512 + c) * L;
        bf16_t* va = XT + base0 + (size_t)(1024 + c) * L;          bf16_t* vb = XT + base1 + (size_t)(1024 + c) * L;
#pragma unroll 2
        for (int i = 0; i < PT; ++i) {
            const int t = tid + NT * i;
            X[phys(t)] = CF(bf2f(va[t]), bf2f(vb[t])); X[phys(L + t)] = CF(0.f, 0.f);
        }
        __syncthreads();
        fft_fwd<N>(X, tid);
#pragma unroll 2
        for (int a = tid; a < N; a += NT) { const int pa = phys(a); X[pa] = cmul(X[pa], SPEC[a]); }
        __syncthreads();
        fft_inv<N>(X, tid);
#pragma unroll 2
        for (int i = 0; i < PT; ++i) {
            const int t = tid + NT * i;
            const cf y = X[phys(t)];
            const cf z1 = CF(bf2f(x1a[t]) * (y.x + bf2f(va[t]) * sk0), bf2f(x1b[t]) * (y.y + bf2f(vb[t]) * sk0));
            ZST[t] = z1;
            X[phys(t)] = z1; X[phys(L + t)] = CF(0.f, 0.f);
        }
        __syncthreads();
        fft_fwd<N>(X, tid);
#pragma unroll 2
        for (int a = tid; a < N; a += NT) { const int pa = phys(a); X[pa] = cmul(X[pa], SPEC[16384 + a]); }
        __syncthreads();
        fft_inv<N>(X, tid);
#pragma unroll 2
        for (int i = 0; i < PT; ++i) {
            const int t = tid + NT * i;
            const cf y = X[phys(t)], z1 = ZST[t];
            va[t] = f2bf(bf2f(x2a[t]) * (y.x + z1.x * sk1)); vb[t] = f2bf(bf2f(x2b[t]) * (y.y + z1.y * sk1));
        }
        __syncthreads();
    }
}
__device__ __forceinline__ void phase_hyena(const Params& p, LAS unsigned char* lds) {
    for (int it = blockIdx.x; it < 1024; it += gridDim.x) {
        if (it < 512) hyena_item<8192>(p, lds, it); else hyena_item<4096>(p, lds, it - 512);
    }
}

__device__ __forceinline__ void rope_angle(int pos, int i, float& cs, float& sn) {
    double iv;
    switch (i) {
        case 0: iv = 0.15915494309189535; break; case 1: iv = 0.03086376340470123; break; case 2: iv = 0.005985185712713705; break; case 3: iv = 0.001160663641240061; break;
        case 4: iv = 0.00022507907903927653; break; case 5: iv = 4.364795279280289e-05; break; case 6: iv = 8.464330808241401e-06; break; default: iv = 1.6414262627950345e-06; break;
    }
    double r = (double)pos * iv; r -= floor(r);
    const float x = 2.0f * (float)r;
    cs = cospif(x); sn = sinpif(x);
}
__device__ __forceinline__ void phase_attn(const Params& p, LAS unsigned char* lds) {
    int tid = threadIdx.x; LAUNDER(tid);
    const int lane = tid & 63, wv = tid >> 6, col = lane & 15, quad = lane >> 4;
    const bf16_t* QKV = (const bf16_t*)(p.ws + OFF_BIG);
    bf16_t* ATT = (bf16_t*)(p.ws + OFF_HN);
    LAS bf16_t* Ks = (LAS bf16_t*)lds;
    LAS bf16_t* Vt = (LAS bf16_t*)(lds + 336 * 72 * 2);
    const float* sink = p.in[24];
    constexpr float LOG2E = 1.4426950408889634f;
    for (int it = blockIdx.x; it < 4096; it += gridDim.x) {
        const int tileIdx = it >> 2, kvh = it & 3;
        int L, row0, q0;
        if (tileIdx < 512) { L = 8192; row0 = (tileIdx >> 7) * 8192; q0 = (tileIdx & 127) * 64; }
        else { const int ti = tileIdx - 512; L = 4096; row0 = 32768 + (ti >> 6) * 4096; q0 = (ti & 63) * 64; }
        const int kstart = q0 - 128;
        __syncthreads();
        for (int u = tid; u < 336 * 4; u += NT) {
            const int key = u >> 2, ch = u & 3, pos = kstart + key;
            u32x4 v0 = (u32x4){0u, 0u, 0u, 0u}, v1 = v0;
            if (pos >= 0 && pos < L) {
                const bf16_t* src = QKV + (size_t)(row0 + pos) * 1536 + 1024 + kvh * 64 + ch * 16;
                v0 = *(const u32x4*)src; v1 = *(const u32x4*)(src + 8);
                if (ch == 0) {
                    float a[8], b[8];
#pragma unroll
                    for (int i = 0; i < 4; ++i) { a[2 * i] = __uint_as_float(v0[i] << 16); a[2 * i + 1] = __uint_as_float(v0[i] & 0xffff0000u); b[2 * i] = __uint_as_float(v1[i] << 16); b[2 * i + 1] = __uint_as_float(v1[i] & 0xffff0000u); }
#pragma unroll
                    for (int i = 0; i < 8; ++i) { float cs, sn; rope_angle(pos, i, cs, sn); const float na = a[i] * cs - b[i] * sn, nb = b[i] * cs + a[i] * sn; a[i] = na; b[i] = nb; }
#pragma unroll
                    for (int i = 0; i < 4; ++i) { v0[i] = pk2(a[2 * i], a[2 * i + 1]); v1[i] = pk2(b[2 * i], b[2 * i + 1]); }
                }
            }
            *(LAS u32x4*)(Ks + key * 72 + ch * 16) = v0; *(LAS u32x4*)(Ks + key * 72 + ch * 16 + 8) = v1;
        }
        for (int u = tid; u < 336 * 8; u += NT) {
            const int key = u >> 3, c8 = u & 7, pos = kstart + key;
            u32x4 v = (u32x4){0u, 0u, 0u, 0u};
            if (pos >= 0 && pos < L) v = *(const u32x4*)(QKV + (size_t)(row0 + pos) * 1536 + 1280 + kvh * 64 + c8 * 8);
#pragma unroll
            for (int i = 0; i < 4; ++i) { Vt[(c8 * 8 + 2 * i) * 344 + key] = (bf16_t)(v[i] & 0xffffu); Vt[(c8 * 8 + 2 * i + 1) * 344 + key] = (bf16_t)(v[i] >> 16); }
        }
        __syncthreads();
#pragma unroll 1
        for (int bi = 0; bi < 2; ++bi) {
            const int blk = wv + 8 * bi, g = blk >> 2, qt = blk & 3, h = kvh * 4 + g, qa = q0 + qt * 16;
            const int qpos = qa + col;
            bf16x8 qf[2];
            {
                const bf16_t* qsrc = QKV + (size_t)(row0 + qpos) * 1536 + h * 64;
                u32x4 r0 = *(const u32x4*)(qsrc + quad * 8), r1 = *(const u32x4*)(qsrc + 32 + quad * 8);
                if (quad < 2) {
                    const u32x4 ra = *(const u32x4*)(qsrc), rb = *(const u32x4*)(qsrc + 8);
                    float a[8], b[8];
#pragma unroll
                    for (int i = 0; i < 4; ++i) { a[2 * i] = __uint_as_float(ra[i] << 16); a[2 * i + 1] = __uint_as_float(ra[i] & 0xffff0000u); b[2 * i] = __uint_as_float(rb[i] << 16); b[2 * i + 1] = __uint_as_float(rb[i] & 0xffff0000u); }
                    float o[8];
#pragma unroll
                    for (int i = 0; i < 8; ++i) { float cs, sn; rope_angle(qpos, i, cs, sn); o[i] = (quad == 0) ? (a[i] * cs - b[i] * sn) : (b[i] * cs + a[i] * sn); }
#pragma unroll
                    for (int i = 0; i < 4; ++i) r0[i] = pk2(o[2 * i], o[2 * i + 1]);
                }
                qf[0] = __builtin_bit_cast(bf16x8, r0); qf[1] = __builtin_bit_cast(bf16x8, r1);
            }
            const int kk0 = qt * 16;
            const float sk2 = sink[h] * LOG2E;
            f32x4 sc[18];
            float mx = -1e30f;
#pragma unroll
            for (int j = 0; j < 18; ++j) {
                f32x4 acc = (f32x4){0.f, 0.f, 0.f, 0.f};
#pragma unroll
                for (int ks = 0; ks < 2; ++ks) {
                    const bf16x8 kf = *(const LAS bf16x8*)(Ks + (kk0 + 16 * j + col) * 72 + ks * 32 + quad * 8);
                    acc = __builtin_amdgcn_mfma_f32_16x16x32_bf16(kf, qf[ks], acc, 0, 0, 0);
                }
#pragma unroll
                for (int i = 0; i < 4; ++i) {
                    const int rel = -128 + 16 * j + 4 * quad + i - col, kpos = qpos + rel;
                    const bool valid = (rel >= -128) && (rel <= 128) && (kpos >= 0) && (kpos < L);
                    const float tv = valid ? acc[i] * (0.125f * LOG2E) : -1e30f;
                    acc[i] = tv; mx = fmaxf(mx, tv);
                }
                sc[j] = acc;
                __builtin_amdgcn_sched_barrier(0);
            }
            mx = fmaxf(mx, __shfl_xor(mx, 16, 64)); mx = fmaxf(mx, __shfl_xor(mx, 32, 64));
            mx = fmaxf(mx, sk2);
            float sum = 0.f;
#pragma unroll
            for (int j = 0; j < 18; ++j)
#pragma unroll
                for (int i = 0; i < 4; ++i) { const float pv = exp2f(sc[j][i] - mx); sc[j][i] = pv; sum += pv; }
            sum += __shfl_xor(sum, 16, 64); sum += __shfl_xor(sum, 32, 64);
            const float rden = 1.0f / (sum + exp2f(sk2 - mx));
            f32x4 oacc[4];
#pragma unroll
            for (int dt = 0; dt < 4; ++dt) oacc[dt] = (f32x4){0.f, 0.f, 0.f, 0.f};
#pragma unroll
            for (int gI = 0; gI < 9; ++gI) {
                u32x4 pb; pb.x = pk2(sc[2 * gI][0], sc[2 * gI][1]); pb.y = pk2(sc[2 * gI][2], sc[2 * gI][3]); pb.z = pk2(sc[2 * gI + 1][0], sc[2 * gI + 1][1]); pb.w = pk2(sc[2 * gI + 1][2], sc[2 * gI + 1][3]);
                const bf16x8 pf = __builtin_bit_cast(bf16x8, pb);
#pragma unroll
                for (int dt = 0; dt < 4; ++dt) {
                    const LAS bf16_t* vp = Vt + (dt * 16 + col) * 344 + kk0 + 32 * gI + 4 * quad;
                    const u32x2 lo = *(const LAS u32x2*)vp, hi = *(const LAS u32x2*)(vp + 16);
                    u32x4 vv; vv.x = lo.x; vv.y = lo.y; vv.z = hi.x; vv.w = hi.y;
                    oacc[dt] = __builtin_amdgcn_mfma_f32_16x16x32_bf16(__builtin_bit_cast(bf16x8, vv), pf, oacc[dt], 0, 0, 0);
                }
                __builtin_amdgcn_sched_barrier(0);
            }
            bf16_t* op = ATT + (size_t)(row0 + qpos) * 1024 + h * 64 + 4 * quad;
#pragma unroll
            for (int dt = 0; dt < 4; ++dt) { u32x2 o; o.x = pk2(oacc[dt][0] * rden, oacc[dt][1] * rden); o.y = pk2(oacc[dt][2] * rden, oacc[dt][3] * rden); *(u32x2*)(op + dt * 16) = o; }
        }
    }
}

#if defined(PHASE_TEST)
#define LDSDECL extern __shared__ __attribute__((aligned(16))) unsigned char lds_raw[]; LAS unsigned char* lds = (LAS unsigned char*)lds_raw
__global__ void __launch_bounds__(NT) k_rms(Params p) { phase_rmsnorm(p.in[0], p.in[1], p.in[2], (bf16_t*)p.ws, nullptr); }
__global__ void __launch_bounds__(NT) k_w(Params p) { LDSDECL; phase_weights(p, (LAS float*)lds); }
__global__ void __launch_bounds__(NT) k_fh(Params p) { phase_filter_hidden(p); }
__global__ void __launch_bounds__(NT) k_conf(Params p) { LDSDECL; phase_conformer(p, lds); }
__global__ void __launch_bounds__(NT) k_sc(Params p) { LDSDECL; phase_shortconv_T(p, (LAS float*)lds); }
__global__ void __launch_bounds__(NT) k_zt(Params p) { LDSDECL; phase_zT(p, (LAS float*)lds); }
__global__ void __launch_bounds__(NT) k_hy(Params p) { LDSDECL; phase_hyena(p, lds); }
__global__ void __launch_bounds__(NT) k_attn(Params p) { LDSDECL; phase_attn(p, lds); }
__global__ void __launch_bounds__(NT) k_gbf(Params p, pg8::Gemm g, pg8::EpiBf e) { LDSDECL; pg8::StaticOrder S; S.init(g.M, g.N, gridDim.x, blockIdx.x); pg8::gemm_phase<pg8::EpiBf>(lds, g, S, e); }
__global__ void __launch_bounds__(NT) k_gres(Params p, pg8::Gemm g, pg8::EpiRes e) { LDSDECL; pg8::StaticOrder S; S.init(g.M, g.N, gridDim.x, blockIdx.x); pg8::gemm_phase<pg8::EpiRes>(lds, g, S, e); }
#endif
#define XB_TMO      128
#define XB_XCNT(j)  (256  + 64 * (j))
#define XB_XSUB(j)  (1280 + 64 * (j))
#define XB_XGEN(j)  (2304 + 64 * (j))
#define XB_TOP      3328
#define XB_TOPGEN   3392
#define XCD_BAR_WORDS 3456
#define XB_SPIN_CAP (1u << 22)
__device__ __forceinline__ unsigned xb_ld(unsigned* p)              { return __hip_atomic_load(p, __ATOMIC_RELAXED, __HIP_MEMORY_SCOPE_AGENT); }
__device__ __forceinline__ unsigned xb_add(unsigned* p, unsigned v) { return __hip_atomic_fetch_add(p, v, __ATOMIC_RELAXED, __HIP_MEMORY_SCOPE_AGENT); }
__device__ __forceinline__ unsigned xb_xcc_id() { return (unsigned)__builtin_amdgcn_s_getreg((3 << 11) | 20) & 0xFu; }
#define XB_SPIN(cond, bar) do { unsigned _sp = 0; while (cond) { __builtin_amdgcn_s_sleep(1); \
    if ((++_sp & 255u) == 0u) { if (xb_ld(&(bar)[XB_TMO])) break; if (_sp > XB_SPIN_CAP) { atomicAdd(&(bar)[XB_TMO], 1u); break; } } } } while (0)
struct XcdBarrier { unsigned* bar; unsigned x; volatile LAS unsigned* st; };
__device__ __forceinline__ XcdBarrier xcd_barrier_post(unsigned* bar, volatile LAS unsigned* st) {
    XcdBarrier b; b.bar = bar; b.x = xb_xcc_id(); b.st = st;
    if (threadIdx.x == 0) (void)xb_add(&bar[XB_XCNT(b.x)], 1u);
    return b;
}
__device__ __forceinline__ void xcd_barrier_complete(unsigned* bar, unsigned x, unsigned& nloc, unsigned& nx) {
    const unsigned G = gridDim.x * gridDim.y * gridDim.z;
    unsigned sum, cnt, mine, sp = 0u;
    for (;;) {
        sum = 0u; cnt = 0u; mine = 0u;
#pragma unroll
        for (unsigned j = 0; j < 16; ++j) { const unsigned c = xb_ld(&bar[XB_XCNT(j)]); sum += c; cnt += (c > 0u) ? 1u : 0u; mine = (j == x) ? c : mine; }
        if (sum == G) break;
        __builtin_amdgcn_s_sleep(1);
        if ((++sp & 255u) == 0u) { if (xb_ld(&bar[XB_TMO])) break; if (sp > XB_SPIN_CAP) { atomicAdd(&bar[XB_TMO], 1u); break; } }
    }
    nloc = mine > 0u ? mine : 1u; nx = cnt > 0u ? cnt : 1u;
}
__device__ __forceinline__ void xcd_barrier(const XcdBarrier& b) {
    asm volatile("s_waitcnt vmcnt(0)" ::: "memory");
    __syncthreads();
    if (threadIdx.x == 0) {
        unsigned* bar = b.bar;
        __builtin_amdgcn_s_waitcnt(0);
        unsigned nloc = b.st[0], nx = b.st[1];
        if (nloc == 0u) { xcd_barrier_complete(bar, b.x, nloc, nx); b.st[0] = nloc; b.st[1] = nx; }
        const unsigned old = xb_add(&bar[XB_XSUB(b.x)], 1u);
        const unsigned gen = old / nloc;
        if (old + 1u == (gen + 1u) * nloc) {
            __builtin_amdgcn_fence(__ATOMIC_RELEASE, "agent");
            asm volatile("s_waitcnt vmcnt(0)" ::: "memory");
            const unsigned og = xb_add(&bar[XB_TOP], 1u);
            const unsigned tg = og / nx;
            if (og + 1u == (tg + 1u) * nx) xb_add(&bar[XB_TOPGEN], 1u);
            else XB_SPIN(xb_ld(&bar[XB_TOPGEN]) == tg, bar);
            __builtin_amdgcn_fence(__ATOMIC_ACQUIRE, "agent");
            xb_add(&bar[XB_XGEN(b.x)], 1u);
            asm volatile("s_waitcnt vmcnt(0)" ::: "memory");
        } else {
            XB_SPIN(xb_ld(&bar[XB_XGEN(b.x)]) == gen, bar);
            __builtin_amdgcn_fence(__ATOMIC_ACQUIRE, "agent");
            asm volatile("s_waitcnt vmcnt(0)" ::: "memory");
        }
    }
    __syncthreads();
}

constexpr int NPH = 21;
__global__ void __launch_bounds__(NT) mk_fwd(Params p) {
    extern __shared__ __attribute__((aligned(16))) unsigned char lds_raw[];
    LAS unsigned char* lds = (LAS unsigned char*)lds_raw;
    volatile LAS unsigned* xbst = (volatile LAS unsigned*)(lds + LDS_X_BYTES + 2048);
    if (threadIdx.x == 0) { xbst[0] = 0u; xbst[1] = 0u; }
    __syncthreads();
    XcdBarrier xb{};
    if (p.ph_hi - p.ph_lo > 1) xb = xcd_barrier_post((unsigned*)(p.ws + OFF_BAR), xbst);
    bf16_t* WB = (bf16_t*)p.ws;
    bf16_t* HN = (bf16_t*)(p.ws + OFF_HN);
    bf16_t* BIG = (bf16_t*)(p.ws + OFF_BIG);
    float* X = p.out;
    for (int ph = p.ph_lo; ph < p.ph_hi; ++ph) {
        int kind = 0;
        const float* ng = nullptr;
        pg8::Gemm g{}; pg8::EpiBf eb{}; pg8::EpiRes er{};
        switch (ph) {
            case 0: kind = 10; break;
            case 1: kind = 2; g = pg8::Gemm{HN, (bf16_t*)(p.ws + OFF_WIN), NTOK, 2560, 1024}; eb = pg8::EpiBf{2, (bf16_t*)p.out, 512, (bf16_t*)p.out + (size_t)NTOK * 512}; break;
            case 2: kind = 11; break;
            case 3: kind = 12; break;
            case 4: kind = 13; break;
            case 5: kind = 3; g = pg8::Gemm{HN, (bf16_t*)(p.ws + OFF_WOUT), NTOK, 1024, 1024}; er = pg8::EpiRes{p.in[0], p.in[1], X, 0}; break;
            case 6: kind = 1; ng = p.in[3]; break;
            case 7: case 9: case 16: case 18: {
                const int layer = (ph >= 16), half = (ph == 9 || ph == 18);
                kind = 2; g = pg8::Gemm{HN + (size_t)half * 32768 * 1024, (bf16_t*)(p.ws + OFF_WUP) + (size_t)layer * N_WFF, 32768, 4096, 1024};
                eb = pg8::EpiBf{1, BIG, 4096, nullptr}; break; }
            case 8: case 10: case 17: case 19: {
                const int layer = (ph >= 17), half = (ph == 10 || ph == 19);
                kind = 3; g = pg8::Gemm{BIG, (bf16_t*)(p.ws + OFF_WDN) + (size_t)layer * N_WFF, 32768, 1024, 4096};
                er = pg8::EpiRes{X, X + (size_t)32768 * 1024, X, half * 32768}; break; }
            case 11: kind = 1; ng = p.in[2] + 1024; break;
            case 12: kind = 2; g = pg8::Gemm{HN, (bf16_t*)(p.ws + OFF_WQKV), NTOK, 1536, 1024}; eb = pg8::EpiBf{0, BIG, 1536, nullptr}; break;
            case 13: kind = 14; break;
            case 14: kind = 3; g = pg8::Gemm{HN, (bf16_t*)(p.ws + OFF_WO), NTOK, 1024, 1024}; er = pg8::EpiRes{X, X + (size_t)32768 * 1024, X, 0}; break;
            case 15: kind = 1; ng = p.in[3] + 1024; break;
            case 20: kind = 15; break;
            default: break;
        }
        (void)WB;
        if (kind == 1) phase_rmsnorm(X, X + (size_t)32768 * 1024, ng, HN, nullptr);
        else if (kind == 2) { pg8::StaticOrder S; S.init(g.M, g.N, gridDim.x, blockIdx.x); pg8::gemm_phase<pg8::EpiBf>(lds, g, S, eb); }
        else if (kind == 3) { pg8::StaticOrder S; S.init(g.M, g.N, gridDim.x, blockIdx.x); pg8::gemm_phase<pg8::EpiRes>(lds, g, S, er); }
        else if (kind == 10) { phase_weights(p, (LAS float*)lds); phase_filter_hidden(p); phase_rmsnorm(p.in[0], p.in[1], p.in[2], HN, nullptr); }
        else if (kind == 11) { phase_conformer(p, lds); phase_shortconv_T(p, (LAS float*)lds); }
        else if (kind == 12) phase_hyena(p, lds);
        else if (kind == 13) phase_zT(p, (LAS float*)lds);
        else if (kind == 14) phase_attn(p, lds);
        else if (kind == 15) phase_rmsnorm(X, X + (size_t)32768 * 1024, p.in[4], nullptr, X);
        if (ph + 1 < p.ph_hi) { if (p.ph_hi > 1000) cg::this_grid().sync();   xcd_barrier(xb); }
    }
}

extern "C" void kernel_launch(void* const* d_in, const int* in_sizes, int n_in, void* d_out, int out_size, void* d_ws, size_t ws_size, hipStream_t stream) {
    static int grid = 0;
    if (grid == 0) {
        if (n_in != 28 || ws_size < WS_END) { fprintf(stderr, "kernel_launch: unexpected n_in %d / ws_size %zu (need %zu)\n", n_in, ws_size, (size_t)WS_END); grid = -1; return; }
        int dev = 0, cus = 0, per_cu = 0;
        hipGetDevice(&dev); hipDeviceGetAttribute(&cus, hipDeviceAttributeMultiprocessorCount, dev);
        if (hipFuncSetAttribute((const void*)mk_fwd, hipFuncAttributeMaxDynamicSharedMemorySize, LDS_BYTES) != hipSuccess) { fprintf(stderr, "kernel_launch: hipFuncSetAttribute failed\n"); grid = -1; return; }
        hipOccupancyMaxActiveBlocksPerMultiprocessor(&per_cu, (const void*)mk_fwd, NT, LDS_BYTES);
        if (per_cu < 1) { fprintf(stderr, "kernel_launch: occupancy query says %d blocks per CU\n", per_cu); per_cu = 1; }
        (void)hipGetLastError();
        grid = cus > 256 ? 256 : cus;
    }
    if (grid < 0) return;
    Params p{};
    for (int i = 0; i < 28; ++i) p.in[i] = (const float*)d_in[i];
    p.out = (float*)d_out; p.ws = (unsigned char*)d_ws;
#if MK_MULTI
    for (int ph = 0; ph < NPH; ++ph) {
        p.ph_lo = ph; p.ph_hi = ph + 1;
        hipLaunchKernelGGL(mk_fwd, dim3(grid), dim3(NT), LDS_BYTES, stream, p);
    }
#else
    p.ph_lo = 0; p.ph_hi = NPH;
    if (hipMemsetAsync((char*)d_ws + OFF_BAR, 0, XCD_BAR_BYTES, stream) != hipSuccess) { fprintf(stderr, "kernel_launch: memset of barrier words failed\n"); return; }
    void* args[] = {&p};
    hipError_t e = hipLaunchCooperativeKernel((const void*)mk_fwd, dim3(grid), dim3(NT), args, LDS_BYTES, stream);
    if (e != hipSuccess) fprintf(stderr, "cooperative launch failed: %s (grid %d)\n", hipGetErrorString(e), grid);
#endif
}
#endif
```

```cpp
#include <hip/hip_runtime.h>
#include <hip/hip_cooperative_groups.h>
#include <cstdio>
namespace cg = cooperative_groups;

#ifndef PROBE_MASK
#define PROBE_MASK 0u
#endif
#define PROBE_MULT 4
#ifndef MK_MULTI
#define MK_MULTI 0
#endif

#define LAS __attribute__((address_space(3)))
#if defined(__HIP_DEVICE_COMPILE__)
#define LAUNDER(x) asm volatile("" : "+v"(x))
#else
#define LAUNDER(x)
#endif
typedef unsigned short bf16_t;
typedef short bf16x8 __attribute__((ext_vector_type(8)));
typedef short bf16x4 __attribute__((ext_vector_type(4)));
typedef float f32x4 __attribute__((ext_vector_type(4)));
typedef unsigned u32x4 __attribute__((ext_vector_type(4)));
typedef unsigned u32x2 __attribute__((ext_vector_type(2)));

constexpr int NT = 512;
constexpr int NTOK = 65536;
constexpr int DM = 1024;
constexpr int LDS_X_BYTES = (16384 + 1024) * 8;
constexpr int LDS_BYTES = 147456;
constexpr size_t XCD_BAR_BYTES = 3456 * 4;

constexpr size_t N_WIN = 2560ull * 1024, N_WSQ = 1024ull * 1024, N_WQKV = 1536ull * 1024, N_WFF = 4096ull * 1024;
constexpr size_t OFF_WIN = 0;
constexpr size_t OFF_WOUT = OFF_WIN + N_WIN * 2;
constexpr size_t OFF_WQKV = OFF_WOUT + N_WSQ * 2;
constexpr size_t OFF_WO = OFF_WQKV + N_WQKV * 2;
constexpr size_t OFF_WUP = OFF_WO + N_WSQ * 2;
constexpr size_t OFF_WDN = OFF_WUP + 2 * N_WFF * 2;
constexpr size_t OFF_H3 = OFF_WDN + 2 * N_WFF * 2;
constexpr size_t OFF_HN = OFF_H3 + 12288ull * 64 * 4;
constexpr size_t OFF_BIG = OFF_HN + (size_t)NTOK * 1024 * 2;
constexpr size_t OFF_SPEC = OFF_BIG + (size_t)NTOK * 1536 * 2;
constexpr size_t OFF_ZST = OFF_BIG + 268435456ull;
constexpr size_t OFF_BAR = OFF_ZST + 256ull * 8192 * 8;
constexpr size_t OFF_SS = OFF_BAR + 16384;
constexpr size_t OFF_ROPE = OFF_SS + 5ull * 65536 * 4;
constexpr size_t WS_END = OFF_ROPE + 8192ull * 16 * 4;

struct Params {
    const float* in[28];
    float* out;
    unsigned char* ws;
    int ph_lo, ph_hi;
};

__device__ __forceinline__ float bf2f(bf16_t b) { return __uint_as_float(((unsigned)b) << 16); }
__device__ __forceinline__ bf16_t f2bf(float f) { unsigned u = __float_as_uint(f); u += 0x7FFFu + ((u >> 16) & 1u); return (bf16_t)(u >> 16); }
__device__ __forceinline__ unsigned pk2(float lo, float hi) { unsigned r; asm("v_cvt_pk_bf16_f32 %0, %1, %2" : "=v"(r) : "v"(lo), "v"(hi)); return r; }
__device__ __forceinline__ float wave_sum(float v) {
#pragma unroll
    for (int o = 32; o >= 1; o >>= 1) v += __shfl_xor(v, o, 64);
    return v;
}
__device__ __forceinline__ void seq_of_row(int row, int& L, int& row0) {
    if (row < 32768) { L = 8192; row0 = row & ~8191; } else { L = 4096; row0 = 32768 + ((row - 32768) & ~4095); }
}

namespace pg8 {
constexpr int BM = 256, BK = 64, HALF = 128, HTB = HALF * BK * 2, STAGE_BYTES = 8 * HTB, NXCD = 8, WGM = 8;
__device__ __forceinline__ int lds_byte(int r, int c) { const int st = (r >> 4) * 2 + (c >> 5), rr = r & 15, cc = c & 31, ob = rr * 64 + cc * 2; return st * 1024 + (ob ^ (((ob >> 9) & 1) << 5)); }
__device__ __forceinline__ void stage_rc(int b, int& R, int& C) { const int st = b / 1024, sb = b % 1024, swz = sb ^ (((sb >> 9) & 1) << 5); R = (st >> 1) * 16 + swz / 64; C = (st & 1) * 32 + (swz % 64) / 2; }
__device__ __forceinline__ int perm32(int rho) { const int n = rho >> 4, i = rho & 15; return 8 * (i >> 2) + 4 * n + (i & 3); }
struct Unit { int pm, pn; };
struct Gemm { const bf16_t* A; const bf16_t* Bt; int M, N, K; };
struct StaticOrder {
    int nM, nN, nwg, G, c;
    __device__ __forceinline__ void init(int M, int N, int G_, int c_) { nM = M / BM; nN = N / BM; nwg = nM * nN; G = G_; c = c_; }
    __device__ __forceinline__ bool next(int i, Unit& u) const {
        const long L = (long)i * G + c; if (L >= nwg) return false;
        int wgid = (int)L; { const int q = nwg / NXCD, r = nwg % NXCD, xcd = wgid % NXCD, off = wgid / NXCD; wgid = (xcd < r ? xcd * (q + 1) : r * (q + 1) + (xcd - r) * q) + off; }
        const int nig = WGM * nN, gid = wgid / nig, fm = gid * WGM, gsz = (nM - fm) < WGM ? (nM - fm) : WGM;
        u.pm = fm + ((wgid % nig) % gsz); u.pn = (wgid % nig) / gsz; return true;
    }
};

struct EpiBf {
    static constexpr bool PERM = true;
    int mode; bf16_t* O; int ldc; bf16_t* O2; const float* ss; int ss_off;
    static constexpr int NPRE = 8;
    __device__ __forceinline__ void prefetch(float (&sv)[8], const Unit& u, int wr, int fr) const {
        const int row0 = ss_off + u.pm * BM + wr * 64 + fr;
#pragma unroll
        for (int ai = 0; ai < 2; ++ai)
#pragma unroll
            for (int m = 0; m < 4; ++m) sv[ai * 4 + m] = ss[row0 + ai * HALF + m * 16];
    }
    __device__ __forceinline__ void operator()(const f32x4 (&acc)[2][2][4][2], const float (&sv)[8], const Unit& u, int wr, int wc, int fr, int fq) const {
        const int row0 = u.pm * BM + wr * 64 + fr, colt = u.pn * BM;
#pragma unroll
        for (int ai = 0; ai < 2; ++ai)
#pragma unroll
            for (int m = 0; m < 4; ++m) {
                const size_t row = (size_t)(row0 + ai * HALF + m * 16);
                const float rstd = rsqrtf(sv[ai * 4 + m] * (1.0f / 1024.0f) + 1e-5f);
#pragma unroll
                for (int bj = 0; bj < 2; ++bj) {
                    const int c0 = colt + bj * HALF + wc * 32 + 8 * fq;
                    f32x4 v0 = acc[ai][bj][m][0] * rstd, v1 = acc[ai][bj][m][1] * rstd;
                    if (mode == 2) {
                        if (colt < 1024) {
                            float h[4];
#pragma unroll
                            for (int i = 0; i < 4; ++i) h[i] = v0[i] * __builtin_amdgcn_rcpf(1.0f + __expf(-v1[i]));
                            u32x2 o; o.x = pk2(h[0], h[1]); o.y = pk2(h[2], h[3]);
                            *(u32x2*)(O + row * 512 + (c0 >> 1)) = o;
                        } else {
                            u32x4 o; o.x = pk2(v0[0], v0[1]); o.y = pk2(v0[2], v0[3]); o.z = pk2(v1[0], v1[1]); o.w = pk2(v1[2], v1[3]);
                            *(u32x4*)(O2 + row * 1536 + (c0 - 1024)) = o;
                        }
                    } else {
                        if (mode == 1) {
#pragma unroll
                            for (int i = 0; i < 4; ++i) { float a = fmaxf(v0[i], 0.f), b = fmaxf(v1[i], 0.f); v0[i] = a * a; v1[i] = b * b; }
                        }
                        u32x4 o; o.x = pk2(v0[0], v0[1]); o.y = pk2(v0[2], v0[3]); o.z = pk2(v1[0], v1[1]); o.w = pk2(v1[2], v1[3]);
                        *(u32x4*)(O + row * ldc + c0) = o;
                    }
                }
            }
    }
};
struct EpiRes {
    static constexpr bool PERM = true;
    const float* res_f0; const float* res_f1; const bf16_t* res_b; bf16_t* xout; int row_off; float* ss;
    __device__ __forceinline__ void prefetch(float (&)[8], const Unit&, int, int) const {}
    __device__ __forceinline__ void operator()(const f32x4 (&acc)[2][2][4][2], const float (&)[8], const Unit& u, int wr, int wc, int fr, int fq) const {
        const int row0 = row_off + u.pm * BM + wr * 64 + fr, col0 = u.pn * BM + wc * 32 + 8 * fq;
#pragma unroll
        for (int ai = 0; ai < 2; ++ai) {
            f32x4 r0[4][2], r1[4][2];
            if (res_b) {
                u32x4 t[4][2];
#pragma unroll
                for (int m = 0; m < 4; ++m)
#pragma unroll
                    for (int bj = 0; bj < 2; ++bj) t[m][bj] = *(const u32x4*)(res_b + (size_t)(row0 + ai * HALF + m * 16) * 1024 + col0 + bj * HALF);
#pragma unroll
                for (int m = 0; m < 4; ++m)
#pragma unroll
                    for (int bj = 0; bj < 2; ++bj) {
                        const u32x4 q = t[m][bj];
                        r0[m][bj][0] = __uint_as_float(q.x << 16); r0[m][bj][1] = __uint_as_float(q.x & 0xffff0000u); r0[m][bj][2] = __uint_as_float(q.y << 16); r0[m][bj][3] = __uint_as_float(q.y & 0xffff0000u);
                        r1[m][bj][0] = __uint_as_float(q.z << 16); r1[m][bj][1] = __uint_as_float(q.z & 0xffff0000u); r1[m][bj][2] = __uint_as_float(q.w << 16); r1[m][bj][3] = __uint_as_float(q.w & 0xffff0000u);
                    }
            } else {
#pragma unroll
                for (int m = 0; m < 4; ++m) {
                    const int row = row0 + ai * HALF + m * 16;
                    const float* rp = (row < 32768) ? res_f0 + (size_t)row * 1024 : res_f1 + (size_t)(row - 32768) * 1024;
#pragma unroll
                    for (int bj = 0; bj < 2; ++bj) { r0[m][bj] = *(const f32x4*)(rp + col0 + bj * HALF); r1[m][bj] = *(const f32x4*)(rp + col0 + bj * HALF + 4); }
                }
            }
#pragma unroll
            for (int m = 0; m < 4; ++m) {
                const int row = row0 + ai * HALF + m * 16;
                float part = 0.f;
#pragma unroll
                for (int bj = 0; bj < 2; ++bj) {
                    const f32x4 v0 = r0[m][bj] + acc[ai][bj][m][0], v1 = r1[m][bj] + acc[ai][bj][m][1];
                    part += v0[0] * v0[0] + v0[1] * v0[1] + v0[2] * v0[2] + v0[3] * v0[3] + v1[0] * v1[0] + v1[1] * v1[1] + v1[2] * v1[2] + v1[3] * v1[3];
                    u32x4 o; o.x = pk2(v0[0], v0[1]); o.y = pk2(v0[2], v0[3]); o.z = pk2(v1[0], v1[1]); o.w = pk2(v1[2], v1[3]);
                    *(u32x4*)(xout + (size_t)row * 1024 + col0 + bj * HALF) = o;
                }
                part += __shfl_xor(part, 16, 64); part += __shfl_xor(part, 32, 64);
                if (fq == 0) atomicAdd(ss + row, part);
            }
        }
    }
};

template <class Epi>
__device__ __forceinline__ void gemm_phase(LAS unsigned char* lds, const Gemm g, const StaticOrder& S, const Epi& E) {
    int tid = threadIdx.x; LAUNDER(tid);
    const int wid = __builtin_amdgcn_readfirstlane(tid >> 6), lane = tid & 63, wr = wid >> 2, wc = wid & 3, fr = lane & 15, fq = lane >> 4;
    const int K = g.K, nt = K / BK;
    unsigned voffA[2], voffB[2];
#pragma unroll
    for (int i = 0; i < 2; ++i) { int R, C; stage_rc(tid * 16 + i * 8192, R, C); const int Rb = Epi::PERM ? ((R & ~31) + perm32(R & 31)) : R;
        voffA[i] = (unsigned)(R * K + C) * 2u; voffB[i] = (unsigned)(Rb * K + C) * 2u; }
    const size_t kstep = (size_t)(BK * 2);
    const size_t hstep = (size_t)HALF * K * 2;
    const size_t tstep = 2 * hstep;
    const unsigned ldsw = (unsigned)wid * 1024u;
    const int aoff = lds_byte(wr * 64 + fr, fq * 8), boff = lds_byte(wc * 32 + fr, fq * 8);
#define PG8_SA(b, h) (((b) * 2 + (h)) * HTB)
#define PG8_SB(b, h) ((4 + (b) * 2 + (h)) * HTB)
#define PG8_STAGE(bufoff, gbase, voff) do { _Pragma("unroll") for (int _i = 0; _i < 2; ++_i) \
        __builtin_amdgcn_global_load_lds((const unsigned*)((const char*)(gbase) + (voff)[_i]), (LAS unsigned*)(lds + (bufoff) + ldsw + _i * 8192), 16, 0, 0); } while (0)
#define PG8_LDA(dst, b, h) do { _Pragma("unroll") for (int m = 0; m < 4; ++m) _Pragma("unroll") for (int k = 0; k < 2; ++k) dst[m][k] = *(const LAS bf16x8*)(lds + PG8_SA(b, h) + aoff + m * 2048 + k * 1024); } while (0)
#define PG8_LDB(dst, b, h) do { _Pragma("unroll") for (int n = 0; n < 2; ++n) _Pragma("unroll") for (int k = 0; k < 2; ++k) dst[n][k] = *(const LAS bf16x8*)(lds + PG8_SB(b, h) + boff + n * 2048 + k * 1024); } while (0)
#define PG8_MMA(ai, bj, At, Bt) do { __builtin_amdgcn_s_setprio(1); _Pragma("unroll") for (int m = 0; m < 4; ++m) _Pragma("unroll") for (int n = 0; n < 2; ++n) _Pragma("unroll") for (int k = 0; k < 2; ++k) \
        acc[ai][bj][m][n] = __builtin_amdgcn_mfma_f32_16x16x32_bf16(Bt[n][k], At[m][k], acc[ai][bj][m][n], 0, 0, 0); __builtin_amdgcn_s_setprio(0); } while (0)
#define PG8_WAIT_V(n) asm volatile("s_waitcnt vmcnt(" #n ")" ::: "memory")
#define PG8_WAIT_L(n) asm volatile("s_waitcnt lgkmcnt(" #n ")" ::: "memory")
#define PG8_BAR __builtin_amdgcn_s_barrier()
#define PG8_SCHED __builtin_amdgcn_sched_barrier(0)
    Unit cur, nxt; int ui = 0;
    if (!S.next(0, cur)) return;
    f32x4 acc[2][2][4][2];
#pragma unroll
    for (int a = 0; a < 2; ++a)
#pragma unroll
        for (int b = 0; b < 2; ++b)
#pragma unroll
            for (int m = 0; m < 4; ++m)
#pragma unroll
                for (int n = 0; n < 2; ++n) acc[a][b][m][n] = (f32x4){0.f, 0.f, 0.f, 0.f};
    bf16x8 At[4][2], B0[2][2], B1[2][2];
    const char* cA = (const char*)g.A + (size_t)cur.pm * tstep; const char* cB = (const char*)g.Bt + (size_t)cur.pn * tstep;
    float sv[8] = {0.f, 0.f, 0.f, 0.f, 0.f, 0.f, 0.f, 0.f};
    E.prefetch(sv, cur, wr, fr);
    PG8_STAGE(PG8_SB(0, 0), cB, voffB); PG8_STAGE(PG8_SA(0, 0), cA, voffA); PG8_STAGE(PG8_SB(0, 1), cB + hstep, voffB); PG8_STAGE(PG8_SA(0, 1), cA + hstep, voffA);
    if (wr == 1) PG8_BAR;
    PG8_WAIT_V(4); PG8_BAR;
    PG8_STAGE(PG8_SB(1, 0), cB + kstep, voffB); PG8_STAGE(PG8_SA(1, 0), cA + kstep, voffA); PG8_STAGE(PG8_SB(1, 1), cB + hstep + kstep, voffB);
    PG8_WAIT_V(6); PG8_BAR;
    for (;;) {
        const bool has_next = S.next(ui + 1, nxt);
        const char* nA = has_next ? (const char*)g.A + (size_t)nxt.pm * tstep : cA; const char* nB = has_next ? (const char*)g.Bt + (size_t)nxt.pn * tstep : cB;
        for (int t = 0; t < nt; t += 2) {
            const bool last = (t == nt - 2);
            const char* a1 = cA + (size_t)(t + 1) * kstep;
            const char* a2 = last ? nA : cA + (size_t)(t + 2) * kstep; const char* b2 = last ? nB : cB + (size_t)(t + 2) * kstep;
            const char* a3 = a2 + kstep; const char* b3 = b2 + kstep;
            PG8_LDB(B0, 0, 0); PG8_SCHED; PG8_LDA(At, 0, 0); PG8_STAGE(PG8_SA(1, 1), a1 + hstep, voffA);
            PG8_WAIT_L(8); PG8_BAR; PG8_WAIT_L(0); PG8_MMA(0, 0, At, B0); PG8_BAR; PG8_SCHED;
            PG8_LDB(B1, 0, 1); PG8_STAGE(PG8_SB(0, 0), b2, voffB);
            PG8_BAR; PG8_WAIT_L(0); PG8_MMA(0, 1, At, B1); PG8_BAR;
            PG8_LDA(At, 0, 1); PG8_STAGE(PG8_SA(0, 0), a2, voffA);
            PG8_BAR; PG8_WAIT_L(0); PG8_MMA(1, 0, At, B0); PG8_BAR; PG8_SCHED;
            PG8_STAGE(PG8_SB(0, 1), b2 + hstep, voffB);
            PG8_WAIT_V(6); PG8_BAR; PG8_MMA(1, 1, At, B1); PG8_BAR;
            PG8_LDB(B0, 1, 0); PG8_SCHED; PG8_LDA(At, 1, 0); PG8_STAGE(PG8_SA(0, 1), a2 + hstep, voffA);
            PG8_WAIT_L(8); PG8_BAR; PG8_WAIT_L(0); PG8_MMA(0, 0, At, B0); PG8_BAR; PG8_SCHED;
            PG8_LDB(B1, 1, 1); PG8_STAGE(PG8_SB(1, 0), b3, voffB);
            PG8_BAR; PG8_WAIT_L(0); PG8_MMA(0, 1, At, B1); PG8_BAR;
            PG8_LDA(At, 1, 1); PG8_STAGE(PG8_SA(1, 0), a3, voffA);
            PG8_BAR; PG8_WAIT_L(0); PG8_MMA(1, 0, At, B0); PG8_BAR; PG8_SCHED;
            PG8_STAGE(PG8_SB(1, 1), b3 + hstep, voffB);
            PG8_WAIT_V(6); PG8_BAR; PG8_MMA(1, 1, At, B1); PG8_BAR;
        }
        E(acc, sv, cur, wr, wc, fr, fq);
        if (!has_next) break;
        E.prefetch(sv, nxt, wr, fr);
#pragma unroll
        for (int a = 0; a < 2; ++a)
#pragma unroll
            for (int b = 0; b < 2; ++b)
#pragma unroll
                for (int m = 0; m < 4; ++m)
#pragma unroll
                    for (int n = 0; n < 2; ++n) acc[a][b][m][n] = (f32x4){0.f, 0.f, 0.f, 0.f};
        cur = nxt; cA = nA; cB = nB; ++ui;
    }
    PG8_WAIT_V(0);
    if (wr == 0) PG8_BAR;
    PG8_BAR;
#undef PG8_SA
#undef PG8_SB
#undef PG8_STAGE
#undef PG8_LDA
#undef PG8_LDB
#undef PG8_MMA
#undef PG8_WAIT_V
#undef PG8_WAIT_L
#undef PG8_BAR
#undef PG8_SCHED
}
}

typedef float cf __attribute__((ext_vector_type(2)));
#define CF(a, b) ((cf){(a), (b)})
__host__ __device__ __forceinline__ cf cmul(cf a, cf b) { return CF(a.x * b.x - a.y * b.y, a.x * b.y + a.y * b.x); }
__host__ __device__ __forceinline__ cf cmulc(cf a, cf b) { return CF(a.x * b.x + a.y * b.y, a.y * b.x - a.x * b.y); }
__host__ __device__ __forceinline__ cf cadd(cf a, cf b) { return CF(a.x + b.x, a.y + b.y); }
__host__ __device__ __forceinline__ cf csub(cf a, cf b) { return CF(a.x - b.x, a.y - b.y); }
__host__ __device__ __forceinline__ int phys(int a) { return a + (a >> 4); }
__host__ __device__ __forceinline__ cf w16(int e) {
    switch (e) {
        case 0: return CF(1.0f, 0.0f);
        case 1: return CF(0.9238795325112867f, -0.3826834323650898f);
        case 2: return CF(0.7071067811865476f, -0.7071067811865476f);
        case 3: return CF(0.3826834323650898f, -0.9238795325112867f);
        case 4: return CF(0.0f, -1.0f);
        case 5: return CF(-0.3826834323650898f, -0.9238795325112867f);
        case 6: return CF(-0.7071067811865476f, -0.7071067811865476f);
        default: return CF(-0.9238795325112867f, -0.3826834323650898f);
    }
}
template <int R> __host__ __device__ __forceinline__ constexpr int bitrev_r(int k) {
    return (R == 2) ? k : (R == 4) ? (((k & 1) << 1) | (k >> 1)) : (((k & 1) << 3) | ((k & 2) << 1) | ((k & 4) >> 1) | ((k & 8) >> 3));
}
template <int R> struct LogR { static constexpr int v = (R == 16) ? 4 : (R == 4) ? 2 : 1; };
__host__ __device__ __forceinline__ cf twiddle_base(int n, int M) {
    float s, c; const float x = 2.0f * (float)n / (float)M;
#if defined(__HIP_DEVICE_COMPILE__)
    s = __builtin_amdgcn_sinf(0.5f * x); c = __builtin_amdgcn_cosf(0.5f * x);
#else
    s = (float)sin(3.14159265358979323846 * (double)x); c = (float)cos(3.14159265358979323846 * (double)x);
#endif
    return CF(c, -s);
}
__host__ __device__ __forceinline__ void mulw(float& r, float& i, int e, bool conj) {
    const float c8 = 0.7071067811865476f;
    if (e == 0) return;
    if (e == 4) { const float t = r; if (!conj) { r = i; i = -t; } else { r = -i; i = t; } return; }
    if (e == 2) { const float a = r, b = i; if (!conj) { r = (a + b) * c8; i = (b - a) * c8; } else { r = (a - b) * c8; i = (a + b) * c8; } return; }
    if (e == 6) { const float a = r, b = i; if (!conj) { r = (b - a) * c8; i = -(a + b) * c8; } else { r = -(a + b) * c8; i = (a - b) * c8; } return; }
    const cf w = w16(e); const float wr = w.x, wi = conj ? -w.y : w.y;
    const float a = r, b = i; r = a * wr - b * wi; i = a * wi + b * wr;
}
template <int R> __host__ __device__ __forceinline__ void make_tw(float (&twr)[R], float (&twi)[R], int n, int M) {
    twr[0] = 1.f; twi[0] = 0.f;
    if (R > 1) { const cf b = twiddle_base(n, M); twr[1] = b.x; twi[1] = b.y; }
#pragma unroll
    for (int k = 2; k < R; ++k) {
        const int p = (k & 1) ? k - 1 : k / 2, q = (k & 1) ? 1 : k / 2;
        twr[k] = twr[p] * twr[q] - twi[p] * twi[q]; twi[k] = twr[p] * twi[q] + twi[p] * twr[q];
    }
}

template <int R, bool TW, typename XP> __host__ __device__ __forceinline__ void fwd_pass(XP X, int N, int M, int tid) {
    const int m = M / R, ps = (m >= 16) ? m + (m >> 4) : m;
    LAUNDER(tid);
    const bool shared_n = TW && (NT % m == 0);
    float twr[R], twi[R];
    if (shared_n) make_tw<R>(twr, twi, tid % m, M);
#pragma unroll 2
    for (int g = tid; g < N / R; g += NT) {
        const int n = g % m, B = (g / m) * M, pb = phys(B + n);
        float vr[R], vi[R];
#pragma unroll
        for (int j = 0; j < R; ++j) { const cf t = X[pb + j * ps]; vr[j] = t.x; vi[j] = t.y; }
#pragma unroll
        for (int st = 0; st < LogR<R>::v; ++st) {
            const int h = (R / 2) >> st;
#pragma unroll
            for (int j = 0; j < R; ++j) {
                if ((j & h) == 0) {
                    const float ar = vr[j], ai = vi[j], br = vr[j + h], bi = vi[j + h];
                    vr[j] = ar + br; vi[j] = ai + bi;
                    float dr = ar - br, di = ai - bi;
                    mulw(dr, di, (j % h) * (16 / (2 * h)), false);
                    vr[j + h] = dr; vi[j + h] = di;
                }
            }
        }
        if (TW) {
            if (!shared_n) make_tw<R>(twr, twi, n, M);
#pragma unroll
            for (int k = 0; k < R; ++k) { const int q = bitrev_r<R>(k); X[pb + k * ps] = CF(vr[q] * twr[k] - vi[q] * twi[k], vr[q] * twi[k] + vi[q] * twr[k]); }
        } else {
#pragma unroll
            for (int k = 0; k < R; ++k) { const int q = bitrev_r<R>(k); X[pb + k * ps] = CF(vr[q], vi[q]); }
        }
    }
}
template <int R, bool TW, typename XP> __host__ __device__ __forceinline__ void inv_pass(XP X, int N, int M, int tid) {
    const int m = M / R, ps = (m >= 16) ? m + (m >> 4) : m;
    LAUNDER(tid);
    const bool shared_n = TW && (NT % m == 0);
    float twr[R], twi[R];
    if (shared_n) make_tw<R>(twr, twi, tid % m, M);
#pragma unroll 2
    for (int g = tid; g < N / R; g += NT) {
        const int n = g % m, B = (g / m) * M, pb = phys(B + n);
        float vr[R], vi[R];
        if (TW) {
            if (!shared_n) make_tw<R>(twr, twi, n, M);
#pragma unroll
            for (int k = 0; k < R; ++k) { const cf t = X[pb + k * ps]; const int q = bitrev_r<R>(k); vr[q] = t.x * twr[k] + t.y * twi[k]; vi[q] = t.y * twr[k] - t.x * twi[k]; }
        } else {
#pragma unroll
            for (int k = 0; k < R; ++k) { const cf t = X[pb + k * ps]; const int q = bitrev_r<R>(k); vr[q] = t.x; vi[q] = t.y; }
        }
#pragma unroll
        for (int st = 0; st < LogR<R>::v; ++st) {
            const int h = 1 << st;
#pragma unroll
            for (int j = 0; j < R; ++j) {
                if ((j & h) == 0) {
                    const float ar = vr[j], ai = vi[j]; float br = vr[j + h], bi = vi[j + h];
                    mulw(br, bi, (j % h) * (16 / (2 * h)), true);
                    vr[j] = ar + br; vi[j] = ai + bi; vr[j + h] = ar - br; vi[j + h] = ai - bi;
                }
            }
        }
#pragma unroll
        for (int j = 0; j < R; ++j) X[pb + j * ps] = CF(vr[j], vi[j]);
    }
}
template <int R0, typename XP> __host__ __device__ __forceinline__ void fwd_first_zp(XP X, int N, int tid) {
    const int m = N / R0, ps = m + (m >> 4);
    LAUNDER(tid);
#pragma unroll 2
    for (int n = tid; n < m; n += NT) {
        const int pb = phys(n);
        float twr[R0], twi[R0]; make_tw<R0>(twr, twi, n, N);
        const cf x0 = X[pb];
        if (R0 == 4) {
            const cf x1 = X[pb + ps];
            const float v1r = x0.x + x1.y, v1i = x0.y - x1.x, v2r = x0.x - x1.x, v2i = x0.y - x1.y, v3r = x0.x - x1.y, v3i = x0.y + x1.x;
            X[pb] = CF(x0.x + x1.x, x0.y + x1.y);
            X[pb + ps] = CF(v1r * twr[1] - v1i * twi[1], v1r * twi[1] + v1i * twr[1]);
            X[pb + 2 * ps] = CF(v2r * twr[R0 - 2] - v2i * twi[R0 - 2], v2r * twi[R0 - 2] + v2i * twr[R0 - 2]);
            X[pb + 3 * ps] = CF(v3r * twr[R0 - 1] - v3i * twi[R0 - 1], v3r * twi[R0 - 1] + v3i * twr[R0 - 1]);
        } else {
            X[pb + ps] = CF(x0.x * twr[1] - x0.y * twi[1], x0.x * twi[1] + x0.y * twr[1]);
        }
    }
}
template <int R0, typename XP> __host__ __device__ __forceinline__ void inv_last_lo(XP X, int N, int tid) {
    const int m = N / R0, ps = m + (m >> 4);
    LAUNDER(tid);
#pragma unroll 2
    for (int n = tid; n < m; n += NT) {
        const int pb = phys(n);
        float twr[R0], twi[R0]; make_tw<R0>(twr, twi, n, N);
        float ur[R0], ui[R0];
#pragma unroll
        for (int k = 0; k < R0; ++k) { const cf t = X[pb + k * ps]; ur[k] = t.x * twr[k] + t.y * twi[k]; ui[k] = t.y * twr[k] - t.x * twi[k]; }
        if (R0 == 4) {
            X[pb] = CF(ur[0] + ur[1] + ur[R0 - 2] + ur[R0 - 1], ui[0] + ui[1] + ui[R0 - 2] + ui[R0 - 1]);
            X[pb + ps] = CF((ur[0] - ur[R0 - 2]) - (ui[1] - ui[R0 - 1]), (ui[0] - ui[R0 - 2]) + (ur[1] - ur[R0 - 1]));
        } else {
            X[pb] = CF(ur[0] + ur[1], ui[0] + ui[1]);
        }
    }
}
template <typename XP, typename SP> __host__ __device__ __forceinline__ void mid_pass(XP X, SP spec, int N, int tid) {
    LAUNDER(tid);
#pragma unroll 2
    for (int g = tid; g < N / 16; g += NT) {
        const int pb = 17 * g;
        float vr[16], vi[16];
#pragma unroll
        for (int j = 0; j < 16; ++j) { const cf t = X[pb + j]; vr[j] = t.x; vi[j] = t.y; }
        cf sp[16];
#pragma unroll
        for (int k = 0; k < 16; ++k) sp[k] = spec[16 * g + k];
#pragma unroll
        for (int st = 0; st < 4; ++st) {
            const int h = 8 >> st;
#pragma unroll
            for (int j = 0; j < 16; ++j) {
                if ((j & h) == 0) {
                    const float ar = vr[j], ai = vi[j], br = vr[j + h], bi = vi[j + h];
                    vr[j] = ar + br; vi[j] = ai + bi;
                    float dr = ar - br, di = ai - bi;
                    mulw(dr, di, (j % h) * (16 / (2 * h)), false);
                    vr[j + h] = dr; vi[j + h] = di;
                }
            }
        }
#pragma unroll
        for (int k = 0; k < 16; ++k) { const int q = bitrev_r<16>(k); const float a = vr[q], b = vi[q]; vr[q] = a * sp[k].x - b * sp[k].y; vi[q] = a * sp[k].y + b * sp[k].x; }
#pragma unroll
        for (int st = 0; st < 4; ++st) {
            const int h = 1 << st;
#pragma unroll
            for (int j = 0; j < 16; ++j) {
                if ((j & h) == 0) {
                    const float ar = vr[j], ai = vi[j]; float br = vr[j + h], bi = vi[j + h];
                    mulw(br, bi, (j % h) * (16 / (2 * h)), true);
                    vr[j] = ar + br; vi[j] = ai + bi; vr[j + h] = ar - br; vi[j + h] = ai - bi;
                }
            }
        }
#pragma unroll
        for (int j = 0; j < 16; ++j) X[pb + j] = CF(vr[j], vi[j]);
    }
}
typedef unsigned short hbf16_t;
__host__ __device__ __forceinline__ float hbf2f(hbf16_t b) { return __builtin_bit_cast(float, ((unsigned)b) << 16); }
__host__ __device__ __forceinline__ hbf16_t hf2bf(float f) { unsigned u = __builtin_bit_cast(unsigned, f); u += 0x7FFFu + ((u >> 16) & 1u); return (hbf16_t)(u >> 16); }
template <int R0, typename XP> __host__ __device__ __forceinline__ void first_from_global(XP X, const hbf16_t* va, const hbf16_t* vb, int N, int tid) {
    const int m = N / R0, ps = m + (m >> 4);
    LAUNDER(tid);
#pragma unroll 2
    for (int n = tid; n < m; n += NT) {
        const int pb = phys(n);
        float twr[R0], twi[R0]; make_tw<R0>(twr, twi, n, N);
        const cf x0 = CF(hbf2f(va[n]), hbf2f(vb[n]));
        if (R0 == 4) {
            const cf x1 = CF(hbf2f(va[n + m]), hbf2f(vb[n + m]));
            const float v1r = x0.x + x1.y, v1i = x0.y - x1.x, v2r = x0.x - x1.x, v2i = x0.y - x1.y, v3r = x0.x - x1.y, v3i = x0.y + x1.x;
            X[pb] = CF(x0.x + x1.x, x0.y + x1.y);
            X[pb + ps] = CF(v1r * twr[1] - v1i * twi[1], v1r * twi[1] + v1i * twr[1]);
            X[pb + 2 * ps] = CF(v2r * twr[R0 - 2] - v2i * twi[R0 - 2], v2r * twi[R0 - 2] + v2i * twr[R0 - 2]);
            X[pb + 3 * ps] = CF(v3r * twr[R0 - 1] - v3i * twi[R0 - 1], v3r * twi[R0 - 1] + v3i * twr[R0 - 1]);
        } else {
            X[pb] = x0;
            X[pb + ps] = CF(x0.x * twr[1] - x0.y * twi[1], x0.x * twi[1] + x0.y * twr[1]);
        }
    }
}
template <int R0, int ORD, typename XP> __host__ __device__ __forceinline__ void last_fused(XP X, const hbf16_t* ga, const hbf16_t* gb, hbf16_t* va, hbf16_t* vb, cf* ZST, float sk, int N, int tid) {
    const int m = N / R0, ps = m + (m >> 4);
    LAUNDER(tid);
#pragma unroll 2
    for (int n = tid; n < m; n += NT) {
        const int pb = phys(n);
        float twr[R0], twi[R0]; make_tw<R0>(twr, twi, n, N);
        float ur[R0], ui[R0];
#pragma unroll
        for (int k = 0; k < R0; ++k) { const cf t = X[pb + k * ps]; ur[k] = t.x * twr[k] + t.y * twi[k]; ui[k] = t.y * twr[k] - t.x * twi[k]; }
        cf y[R0 / 2];
        if (R0 == 4) {
            y[0] = CF(ur[0] + ur[1] + ur[R0 - 2] + ur[R0 - 1], ui[0] + ui[1] + ui[R0 - 2] + ui[R0 - 1]);
            y[R0 / 2 - 1] = CF((ur[0] - ur[R0 - 2]) - (ui[1] - ui[R0 - 1]), (ui[0] - ui[R0 - 2]) + (ur[1] - ur[R0 - 1]));
        } else {
            y[0] = CF(ur[0] + ur[1], ui[0] + ui[1]);
        }
        cf z[R0 / 2];
#pragma unroll
        for (int e = 0; e < R0 / 2; ++e) {
            const int t = n + e * m;
            if (ORD == 0) {
                z[e] = CF(hbf2f(ga[t]) * (y[e].x + hbf2f(va[t]) * sk), hbf2f(gb[t]) * (y[e].y + hbf2f(vb[t]) * sk));
                ZST[t] = z[e];
            } else {
                const cf z1 = ZST[t];
                va[t] = hf2bf(hbf2f(ga[t]) * (y[e].x + z1.x * sk)); vb[t] = hf2bf(hbf2f(gb[t]) * (y[e].y + z1.y * sk));
            }
        }
        if (ORD == 0) {
            const cf x0 = z[0];
            if (R0 == 4) {
                const cf x1 = z[R0 / 2 - 1];
                const float v1r = x0.x + x1.y, v1i = x0.y - x1.x, v2r = x0.x - x1.x, v2i = x0.y - x1.y, v3r = x0.x - x1.y, v3i = x0.y + x1.x;
                X[pb] = CF(x0.x + x1.x, x0.y + x1.y);
                X[pb + ps] = CF(v1r * twr[1] - v1i * twi[1], v1r * twi[1] + v1i * twr[1]);
                X[pb + 2 * ps] = CF(v2r * twr[R0 - 2] - v2i * twi[R0 - 2], v2r * twi[R0 - 2] + v2i * twr[R0 - 2]);
                X[pb + 3 * ps] = CF(v3r * twr[R0 - 1] - v3i * twi[R0 - 1], v3r * twi[R0 - 1] + v3i * twr[R0 - 1]);
            } else {
                X[pb] = x0;
                X[pb + ps] = CF(x0.x * twr[1] - x0.y * twi[1], x0.x * twi[1] + x0.y * twr[1]);
            }
        }
    }
}
#if !defined(FFT_HOST_TEST)
#define FFT_SYNC() __syncthreads()
template <int N, bool ZP> __device__ __forceinline__ void fft_fwd(LAS cf* X, int tid) {
    if (ZP) fwd_first_zp<N / 4096>(X, N, tid); else fwd_pass<N / 4096, true>(X, N, N, tid);
    FFT_SYNC();
    fwd_pass<16, true>(X, N, 4096, tid); FFT_SYNC();
    fwd_pass<16, true>(X, N, 256, tid); FFT_SYNC();
    fwd_pass<16, false>(X, N, 16, tid); FFT_SYNC();
}
template <int N> __device__ __forceinline__ void fft_conv(LAS cf* X, const cf* spec, int tid) {
    fwd_first_zp<N / 4096>(X, N, tid); FFT_SYNC();
    fwd_pass<16, true>(X, N, 4096, tid); FFT_SYNC();
    fwd_pass<16, true>(X, N, 256, tid); FFT_SYNC();
    mid_pass(X, spec, N, tid); FFT_SYNC();
    inv_pass<16, true>(X, N, 256, tid); FFT_SYNC();
    inv_pass<16, true>(X, N, 4096, tid); FFT_SYNC();
    inv_last_lo<N / 4096>(X, N, tid); FFT_SYNC();
}
template <int N> __device__ __forceinline__ void conv_core(LAS cf* X, const cf* spec, int tid) {
    fwd_pass<16, true>(X, N, 4096, tid); FFT_SYNC();
    fwd_pass<16, true>(X, N, 256, tid); FFT_SYNC();
    mid_pass(X, spec, N, tid); FFT_SYNC();
    inv_pass<16, true>(X, N, 256, tid); FFT_SYNC();
    inv_pass<16, true>(X, N, 4096, tid); FFT_SYNC();
}
template <int N> __device__ __forceinline__ void fft_inv(LAS cf* X, int tid) {
    inv_pass<16, false>(X, N, 16, tid); FFT_SYNC();
    inv_pass<16, true>(X, N, 256, tid); FFT_SYNC();
    inv_pass<16, true>(X, N, 4096, tid); FFT_SYNC();
    inv_last_lo<N / 4096>(X, N, tid); FFT_SYNC();
}
#endif

#if !defined(FFT_HOST_TEST)
__device__ __forceinline__ void phase_rmsnorm(const float* src0, const float* src1, const float* g, bf16_t* dst_bf, float* dst_f) {
    int tid = threadIdx.x; LAUNDER(tid);
    const int lane = tid & 63, wv = tid >> 6;
    const int gw = blockIdx.x * 8 + wv, nw = gridDim.x * 8;
    f32x4 gv[4];
#pragma unroll
    for (int i = 0; i < 4; ++i) gv[i] = *(const f32x4*)(g + 4 * (lane + 64 * i));
    for (int row = gw; row < NTOK; row += nw) {
        const float* src = (row < 32768) ? src0 + (size_t)row * 1024 : src1 + (size_t)(row - 32768) * 1024;
        f32x4 v[4]; float ss = 0.f;
#pragma unroll
        for (int i = 0; i < 4; ++i) { v[i] = *(const f32x4*)(src + 4 * (lane + 64 * i)); ss += v[i][0] * v[i][0] + v[i][1] * v[i][1] + v[i][2] * v[i][2] + v[i][3] * v[i][3]; }
        ss = wave_sum(ss);
        const float rstd = rsqrtf(ss * (1.0f / 1024.0f) + 1e-5f);
#pragma unroll
        for (int i = 0; i < 4; ++i) {
            f32x4 o = v[i] * rstd * gv[i];
            if (dst_bf) { u32x2 p; p.x = pk2(o[0], o[1]); p.y = pk2(o[2], o[3]); *(u32x2*)(dst_bf + (size_t)row * 1024 + 4 * (lane + 64 * i)) = p; }
            else *(f32x4*)(dst_f + (size_t)row * 1024 + 4 * (lane + 64 * i)) = o;
        }
    }
}

__device__ __forceinline__ void phase_prep_x(const Params& p) {
    int tid = threadIdx.x; LAUNDER(tid);
    const int lane = tid & 63, wv = tid >> 6;
    const int gw = blockIdx.x * 8 + wv, nw = gridDim.x * 8;
    bf16_t* XB = (bf16_t*)(p.ws + OFF_HN); float* SS = (float*)(p.ws + OFF_SS);
    for (int i = blockIdx.x * NT + tid; i < 4 * 65536; i += gridDim.x * NT) SS[65536 + i] = 0.f;
    for (int row = gw; row < NTOK; row += 2 * nw) {
        const int rowB = row + nw;
        const bool hasB = rowB < NTOK;
        const float* srcA = (row < 32768) ? p.in[0] + (size_t)row * 1024 : p.in[1] + (size_t)(row - 32768) * 1024;
        const float* srcB = hasB ? ((rowB < 32768) ? p.in[0] + (size_t)rowB * 1024 : p.in[1] + (size_t)(rowB - 32768) * 1024) : srcA;
        f32x4 va[4], vb[4];
#pragma unroll
        for (int i = 0; i < 4; ++i) { va[i] = *(const f32x4*)(srcA + 4 * (lane + 64 * i)); vb[i] = *(const f32x4*)(srcB + 4 * (lane + 64 * i)); }
        float ssA = 0.f, ssB = 0.f;
#pragma unroll
        for (int i = 0; i < 4; ++i) {
            ssA += va[i][0] * va[i][0] + va[i][1] * va[i][1] + va[i][2] * va[i][2] + va[i][3] * va[i][3];
            ssB += vb[i][0] * vb[i][0] + vb[i][1] * vb[i][1] + vb[i][2] * vb[i][2] + vb[i][3] * vb[i][3];
            u32x2 o; o.x = pk2(va[i][0], va[i][1]); o.y = pk2(va[i][2], va[i][3]); *(u32x2*)(XB + (size_t)row * 1024 + 4 * (lane + 64 * i)) = o;
            if (hasB) { u32x2 q; q.x = pk2(vb[i][0], vb[i][1]); q.y = pk2(vb[i][2], vb[i][3]); *(u32x2*)(XB + (size_t)rowB * 1024 + 4 * (lane + 64 * i)) = q; }
        }
        ssA = wave_sum(ssA); ssB = wave_sum(ssB);
        if (lane == 0) { SS[row] = ssA; if (hasB) SS[rowB] = ssB; }
    }
}
__device__ __forceinline__ void phase_final_norm(const Params& p) {
    int tid = threadIdx.x; LAUNDER(tid);
    const float* SS4 = (const float*)(p.ws + OFF_SS) + 4 * 65536; const float* g = p.in[4];
    const u32x4* XB = (const u32x4*)(p.ws + OFF_BIG);
    for (size_t i = (size_t)blockIdx.x * NT + tid; i < (size_t)NTOK * 128; i += (size_t)gridDim.x * NT) {
        const int row = (int)(i >> 7), c8 = (int)(i & 127);
        const float rstd = rsqrtf(SS4[row] * (1.0f / 1024.0f) + 1e-5f);
        const u32x4 t = XB[i];
        const f32x4 g0 = *(const f32x4*)(g + 8 * c8), g1 = *(const f32x4*)(g + 8 * c8 + 4);
        f32x4 o0, o1;
        o0[0] = __uint_as_float(t.x << 16); o0[1] = __uint_as_float(t.x & 0xffff0000u); o0[2] = __uint_as_float(t.y << 16); o0[3] = __uint_as_float(t.y & 0xffff0000u);
        o1[0] = __uint_as_float(t.z << 16); o1[1] = __uint_as_float(t.z & 0xffff0000u); o1[2] = __uint_as_float(t.w << 16); o1[3] = __uint_as_float(t.w & 0xffff0000u);
        float* op = p.out + (size_t)row * 1024 + 8 * c8;
        *(f32x4*)op = o0 * rstd * g0; *(f32x4*)(op + 4) = o1 * rstd * g1;
    }
}

__device__ __forceinline__ void phase_weights(const Params& p, LAS float* T) {
    int tid = threadIdx.x; LAUNDER(tid);
    for (int mi = 0; mi < 8; ++mi) {
        const float* src; bf16_t* dst; int K, N; bool perm = false; const float* gain = nullptr;
        switch (mi) {
            case 0: src = p.in[5]; dst = (bf16_t*)(p.ws + OFF_WIN); K = 1024; N = 2560; perm = true; gain = p.in[2]; break;
            case 1: src = p.in[6]; dst = (bf16_t*)(p.ws + OFF_WOUT); K = 1024; N = 1024; break;
            case 2: src = p.in[23]; dst = (bf16_t*)(p.ws + OFF_WQKV); K = 1024; N = 1536; gain = p.in[2] + 1024; break;
            case 3: src = p.in[25]; dst = (bf16_t*)(p.ws + OFF_WO); K = 1024; N = 1024; break;
            case 4: src = p.in[26]; dst = (bf16_t*)(p.ws + OFF_WUP); K = 1024; N = 4096; gain = p.in[3]; break;
            case 5: src = p.in[26] + N_WFF; dst = (bf16_t*)(p.ws + OFF_WUP) + N_WFF; K = 1024; N = 4096; gain = p.in[3] + 1024; break;
            case 6: src = p.in[27]; dst = (bf16_t*)(p.ws + OFF_WDN); K = 4096; N = 1024; break;
            default: src = p.in[27] + N_WFF; dst = (bf16_t*)(p.ws + OFF_WDN) + N_WFF; K = 4096; N = 1024; break;
        }
        const int tk = K / 64, tn = N / 64;
        float rv[8];
        int it = blockIdx.x;
        if (it < tk * tn) {
            const int k0 = (it / tn) * 64, n0 = (it % tn) * 64;
#pragma unroll
            for (int i = 0; i < 8; ++i) { const int idx = tid + NT * i, r = idx >> 6, c = idx & 63; rv[i] = src[(size_t)(k0 + r) * N + n0 + c] * (gain ? gain[k0 + r] : 1.0f); }
        }
        for (; it < tk * tn; it += gridDim.x) {
            const int k0 = (it / tn) * 64, n0 = (it % tn) * 64;
#pragma unroll
            for (int i = 0; i < 8; ++i) { const int idx = tid + NT * i, r = idx >> 6, c = idx & 63; T[r * 65 + c] = rv[i]; }
            __syncthreads();
            const int nit = it + gridDim.x;
            if (nit < tk * tn) {
                const int k1 = (nit / tn) * 64, n1 = (nit % tn) * 64;
#pragma unroll
                for (int i = 0; i < 8; ++i) { const int idx = tid + NT * i, r = idx >> 6, c = idx & 63; rv[i] = src[(size_t)(k1 + r) * N + n1 + c] * (gain ? gain[k1 + r] : 1.0f); }
            }
#pragma unroll
            for (int i = 0; i < 8; ++i) {
                const int idx = tid + NT * i, nl = idx >> 6, kl = idx & 63; int n = n0 + nl;
                if (perm && n < 1024) { const int nn = n & 511, q = nn >> 2, e = nn & 3; n = 8 * q + e + ((n >= 512) ? 4 : 0); }
                dst[(size_t)n * K + k0 + kl] = f2bf(T[kl * 65 + nl]);
            }
            __syncthreads();
        }
    }
}

__device__ __forceinline__ void phase_filter_hidden(const Params& p, LAS float* WL) {
    int tid = threadIdx.x; LAUNDER(tid);
    const int lane = tid & 63, wv = tid >> 6;
    const int gw = blockIdx.x * 8 + wv, nw = gridDim.x * 8;
    const float* w1 = p.in[13]; const float* b1 = p.in[14]; const float* w2 = p.in[15]; const float* b2 = p.in[16];
    const float* w3 = p.in[17]; const float* b3 = p.in[18]; const float* fr = p.in[20];
    float* H3 = (float*)(p.ws + OFF_H3);
    LAS float* w1r = WL; LAS float* w2r = WL + 33 * 64; LAS float* w3r = w2r + 64 * 64;
    __syncthreads();
    for (int i = tid; i < 33 * 64; i += NT) w1r[i] = w1[i];
    for (int i = tid; i < 64 * 64; i += NT) { w2r[i] = w2[i]; w3r[i] = w3[i]; }
    __syncthreads();
    const float bb1 = b1[lane], bb2 = b2[lane], bb3 = b3[lane], f1 = fr[lane], f2 = fr[64 + lane], f3 = fr[128 + lane];
    for (int pg = gw; pg < 12288; pg += nw) {
        const int L = (pg < 8192) ? 8192 : 4096, pos = (pg < 8192) ? pg : pg - 8192;
        const float t = (float)pos / (float)(L - 1);
        const float w = 6.283185307179586f * (float)pos / (float)L;
        float z = 0.f;
        if (lane == 0) z = t;
        else if (lane <= 32) {
            const int bi = (lane - 1) & 15;
            const float f = 1e-4f + (float)bi * ((15.0f - 1e-4f) / 15.0f);
            const float a = w * f;
            z = (lane <= 16) ? cosf(a) : -sinf(a);
        }
        float a1 = bb1;
#pragma unroll 3
        for (int i = 0; i < 33; ++i) a1 += __shfl(z, i, 64) * w1r[i * 64 + lane];
        const float h1 = sinf(f1 * a1);
        float a2 = bb2;
#pragma unroll 8
        for (int i = 0; i < 64; ++i) a2 += __shfl(h1, i, 64) * w2r[i * 64 + lane];
        const float h2 = sinf(f2 * a2);
        float a3 = bb3;
#pragma unroll 8
        for (int i = 0; i < 64; ++i) a3 += __shfl(h2, i, 64) * w3r[i * 64 + lane];
        const float h3 = sinf(f3 * a3);
        H3[(size_t)pg * 64 + lane] = h3;
    }
}

__device__ __forceinline__ void phase_conformer(const Params& p, LAS unsigned char* lds) {
    int tid = threadIdx.x; LAUNDER(tid);
    const int lane = tid & 63, wv = tid >> 6;
    const bf16_t* HCV = (const bf16_t*)p.out;
    bf16_t* YCAT = (bf16_t*)(p.ws + OFF_HN);
    LAS bf16_t* hb = (LAS bf16_t*)lds;
    LAS float* ob = (LAS float*)(lds + 62 * 512 * 2);
    const float* dw = p.in[7]; const float* db = p.in[8]; const float* lg = p.in[9]; const float* lb = p.in[10];
    float w[31];
#pragma unroll
    for (int k = 0; k < 31; ++k) w[k] = dw[k * 512 + tid];
    const float bias = db[tid];
    float gg[8], bb[8];
#pragma unroll
    for (int i = 0; i < 8; ++i) { gg[i] = lg[lane * 8 + i]; bb[i] = lb[lane * 8 + i]; }
    u32x4 pre[8];
    auto cf_load = [&](int item) {
        const int rowbase = item * 32; int L, row0; seq_of_row(rowbase, L, row0);
        const int t0 = rowbase - row0;
#pragma unroll
        for (int k = 0; k < 8; ++k) {
            const int idx = tid + NT * k, r = idx >> 6, c8 = idx & 63, t = t0 - 15 + r;
            pre[k] = (u32x4){0u, 0u, 0u, 0u};
            if (idx < 62 * 64 && t >= 0 && t < L) pre[k] = *(const u32x4*)(HCV + (size_t)(row0 + t) * 512 + c8 * 8);
        }
    };
    if ((int)blockIdx.x < NTOK / 32) cf_load(blockIdx.x);
    for (int it = blockIdx.x; it < NTOK / 32; it += gridDim.x) {
        const int rowbase = it * 32;
#pragma unroll
        for (int k = 0; k < 8; ++k) { const int idx = tid + NT * k, r = idx >> 6, c8 = idx & 63; if (idx < 62 * 64) *(LAS u32x4*)(hb + r * 512 + c8 * 8) = pre[k]; }
        __syncthreads();
        if (it + (int)gridDim.x < NTOK / 32) cf_load(it + gridDim.x);
        float acc[32];
#pragma unroll
        for (int i = 0; i < 32; ++i) acc[i] = bias;
#pragma unroll
        for (int r = 0; r < 62; ++r) {
            const float val = bf2f(hb[r * 512 + tid]);
#pragma unroll
            for (int tt = 0; tt < 32; ++tt) { if (r - tt >= 0 && r - tt < 31) acc[tt] += w[r - tt] * val; }
        }
#pragma unroll
        for (int tt = 0; tt < 32; ++tt) ob[tt * 512 + tid] = acc[tt];
        __syncthreads();
#pragma unroll
        for (int i = 0; i < 4; ++i) {
            const int tt = wv + 8 * i;
            f32x4 v0 = *(const LAS f32x4*)(ob + tt * 512 + lane * 8), v1 = *(const LAS f32x4*)(ob + tt * 512 + lane * 8 + 4);
            float s = v0[0] + v0[1] + v0[2] + v0[3] + v1[0] + v1[1] + v1[2] + v1[3];
            s = wave_sum(s); const float mu = s * (1.0f / 512.0f);
            float x[8]; float q = 0.f;
#pragma unroll
            for (int j = 0; j < 4; ++j) { x[j] = v0[j] - mu; x[4 + j] = v1[j] - mu; }
#pragma unroll
            for (int j = 0; j < 8; ++j) q += x[j] * x[j];
            q = wave_sum(q); const float rstd = rsqrtf(q * (1.0f / 512.0f) + 1e-5f);
            float y[8];
#pragma unroll
            for (int j = 0; j < 8; ++j) { const float a = x[j] * rstd * gg[j] + bb[j]; y[j] = a * __builtin_amdgcn_rcpf(1.0f + __expf(-a)); }
            u32x4 o; o.x = pk2(y[0], y[1]); o.y = pk2(y[2], y[3]); o.z = pk2(y[4], y[5]); o.w = pk2(y[6], y[7]);
            *(u32x4*)(YCAT + (size_t)(rowbase + tt) * 1024 + lane * 8) = o;
        }
        __syncthreads();
    }
}

__device__ __forceinline__ void phase_shortconv_T(const Params& p, LAS float* U) {
    int tid = threadIdx.x; LAUNDER(tid);
    const bf16_t* UHY = (const bf16_t*)p.out + (size_t)NTOK * 512;
    bf16_t* XT = (bf16_t*)(p.ws + OFF_BIG);
    const float* sw = p.in[11]; const float* sb = p.in[12];
    const int lane = tid & 63, wv = __builtin_amdgcn_readfirstlane(tid >> 6);
    u32x4 pre[5];
    constexpr int NIT = (NTOK / 128) * 12;
    auto sc_load = [&](int item) {
        const int tile = item / 12, cht = item % 12, rowbase = tile * 128; int L, row0; seq_of_row(rowbase, L, row0);
        const int t0 = rowbase - row0;
#pragma unroll
        for (int k = 0; k < 5; ++k) {
            const int idx = tid + NT * k, r = idx >> 4, c8 = idx & 15, t = t0 - 1 + r;
            pre[k] = (u32x4){0u, 0u, 0u, 0u};
            if (idx < 130 * 16 && t >= 0 && t < L) pre[k] = *(const u32x4*)(UHY + (size_t)(row0 + t) * 1536 + cht * 128 + c8 * 8);
        }
    };
    if ((int)blockIdx.x < NIT) sc_load(blockIdx.x);
    for (int it = blockIdx.x; it < NIT; it += gridDim.x) {
        const int tile = it / 12, cht = it % 12, rowbase = tile * 128; int L, row0; seq_of_row(rowbase, L, row0);
        const int t0 = rowbase - row0;
#pragma unroll
        for (int k = 0; k < 5; ++k) {
            const int idx = tid + NT * k, r = idx >> 4, c8 = idx & 15;
            if (idx < 130 * 16) {
                const u32x4 v = pre[k];
                LAS float* d = U + r * 129 + c8 * 8;
                d[0] = __uint_as_float(v.x << 16); d[1] = __uint_as_float(v.x & 0xffff0000u);
                d[2] = __uint_as_float(v.y << 16); d[3] = __uint_as_float(v.y & 0xffff0000u);
                d[4] = __uint_as_float(v.z << 16); d[5] = __uint_as_float(v.z & 0xffff0000u);
                d[6] = __uint_as_float(v.w << 16); d[7] = __uint_as_float(v.w & 0xffff0000u);
            }
        }
        __syncthreads();
        if (it + (int)gridDim.x < NIT) sc_load(it + gridDim.x);
#pragma unroll 4
        for (int i = 0; i < 16; ++i) {
            const int chl = wv + 8 * i, ch = cht * 128 + chl;
            const float w0 = sw[ch], w1 = sw[1536 + ch], w2 = sw[3072 + ch], bs = sb[ch];
            const float u0 = U[(2 * lane) * 129 + chl], u1 = U[(2 * lane + 1) * 129 + chl], u2 = U[(2 * lane + 2) * 129 + chl], u3 = U[(2 * lane + 3) * 129 + chl];
            *(unsigned*)(XT + (size_t)row0 * 1536 + (size_t)ch * L + t0 + 2 * lane) = pk2(bs + w0 * u0 + w1 * u1 + w2 * u2, bs + w0 * u1 + w1 * u2 + w2 * u3);
        }
        __syncthreads();
    }
}

__device__ __forceinline__ void phase_zT(const Params& p, LAS float* U) {
    int tid = threadIdx.x; LAUNDER(tid);
    const bf16_t* XT = (const bf16_t*)(p.ws + OFF_BIG);
    bf16_t* YCAT = (bf16_t*)(p.ws + OFF_HN);
    unsigned pre[8];
    constexpr int NIT = (NTOK / 128) * 8;
    auto zt_load = [&](int item) {
        const int tile = item / 8, cht = item % 8, rowbase = tile * 128; int L, row0; seq_of_row(rowbase, L, row0);
        const int t0 = rowbase - row0;
#pragma unroll
        for (int i = 0; i < 8; ++i) { const int idx = tid + NT * i, chl = idx >> 6, tp = idx & 63; pre[i] = *(const unsigned*)(XT + (size_t)row0 * 1536 + (size_t)(1024 + cht * 64 + chl) * L + t0 + 2 * tp); }
    };
    if ((int)blockIdx.x < NIT) zt_load(blockIdx.x);
    for (int it = blockIdx.x; it < NIT; it += gridDim.x) {
        const int tile = it / 8, cht = it % 8, rowbase = tile * 128;
#pragma unroll
        for (int i = 0; i < 8; ++i) { const int idx = tid + NT * i, chl = idx >> 6, tp = idx & 63; U[chl * 129 + 2 * tp] = __uint_as_float(pre[i] << 16); U[chl * 129 + 2 * tp + 1] = __uint_as_float(pre[i] & 0xffff0000u); }
        __syncthreads();
        if (it + (int)gridDim.x < NIT) zt_load(it + gridDim.x);
#pragma unroll
        for (int i = 0; i < 8; ++i) {
            const int idx = tid + NT * i, tl = idx >> 5, cp = idx & 31;
            *(unsigned*)(YCAT + (size_t)(rowbase + tl) * 1024 + 512 + cht * 64 + 2 * cp) = pk2(U[(2 * cp) * 129 + tl], U[(2 * cp + 1) * 129 + tl]);
        }
        __syncthreads();
    }
}

__device__ __forceinline__ float block_sum(float v, LAS float* red, int tid) {
    v = wave_sum(v);
    __syncthreads();
    if ((tid & 63) == 0) red[tid >> 6] = v;
    __syncthreads();
    float s = 0.f;
#pragma unroll
    for (int i = 0; i < 8; ++i) s += red[i];
    return s;
}
template <int L> __device__ __forceinline__ void hyena_item(const Params& p, LAS unsigned char* lds, int c) {
    constexpr int N = 2 * L, PT = L / NT;
    constexpr int NSEQ = (L == 8192) ? 4 : 8, SEQ0ROW = (L == 8192) ? 0 : 32768;
    int tid = threadIdx.x; LAUNDER(tid);
    LAS cf* X = (LAS cf*)lds;
    LAS float* red = (LAS float*)(lds + LDS_X_BYTES);
    const float* KT = p.out + ((L == 8192) ? 0 : (size_t)2048 * 8192);
    const float* skip = p.in[22];
    cf* SPEC = (cf*)(p.ws + OFF_SPEC) + (size_t)blockIdx.x * 2 * 16384;
    bf16_t* XT = (bf16_t*)(p.ws + OFF_BIG);
    cf* ZST = (cf*)(p.ws + OFF_ZST) + (size_t)blockIdx.x * 8192;
    __syncthreads();
#pragma unroll 1
    for (int ord = 0; ord < 2; ++ord) {
        const float* kf = KT + (size_t)((2 * ord) * 512 + c) * L; const float* kb = KT + (size_t)((2 * ord + 1) * 512 + c) * L;
        float ss = 0.f;
#pragma unroll 4
        for (int i = 0; i < PT; ++i) {
            const int t = tid + NT * i;
            const float a0 = kf[t], a1 = kb[t];
            ss += a0 * a0 + ((t > 0) ? a1 * a1 : 0.f);
            X[phys(t)] = CF(a0, 0.f);
            if (t > 0) X[phys(N - t)] = CF(a1, 0.f); else X[phys(L)] = CF(0.f, 0.f);
        }
        ss = block_sum(ss, red, tid);
        const float sc = rsqrtf(ss + 1e-6f) * (1.0f / (float)N);
        __syncthreads();
        fft_fwd<N, false>(X, tid);
#pragma unroll 4
        for (int a = tid; a < N; a += NT) { const cf v = X[phys(a)]; SPEC[ord * 16384 + a] = CF(v.x * sc, v.y * sc); }
        __syncthreads();
    }
    const float sk0 = skip[c], sk1 = skip[512 + c];
    for (int pr = 0; pr < NSEQ / 2; ++pr) {
        const size_t base0 = (size_t)(SEQ0ROW + (2 * pr) * L) * 1536, base1 = (size_t)(SEQ0ROW + (2 * pr + 1) * L) * 1536;
        const bf16_t* x1a = XT + base0 + (size_t)c * L;            const bf16_t* x1b = XT + base1 + (size_t)c * L;
        const bf16_t* x2a = XT + base0 + (size_t)(512 + c) * L;    const bf16_t* x2b = XT + base1 + (size_t)(512 + c) * L;
        bf16_t* va = XT + base0 + (size_t)(1024 + c) * L;          bf16_t* vb = XT + base1 + (size_t)(1024 + c) * L;
        first_from_global<N / 4096>(X, va, vb, N, tid); __syncthreads();
        conv_core<N>(X, SPEC, tid);
        last_fused<N / 4096, 0>(X, x1a, x1b, va, vb, ZST, sk0, N, tid); __syncthreads();
        conv_core<N>(X, SPEC + 16384, tid);
        last_fused<N / 4096, 1>(X, x2a, x2b, va, vb, ZST, sk1, N, tid); __syncthreads();
    }
}
__device__ __forceinline__ void phase_filters(const Params& p, LAS unsigned char* lds) {
    int tid = threadIdx.x; LAUNDER(tid);
    LAS float* Hs = (LAS float*)lds;
    LAS float* Ws = Hs + 256 * 65;
    const float* w4 = p.in[19]; const float* decay = p.in[21];
    const int tl = tid & 255, cg = __builtin_amdgcn_readfirstlane(tid >> 8);
    f32x4 ph[8], pw[2];
    auto fl_load = [&](int item) {
        int tt, ct; const float* H3;
        if (item < 1024) { tt = item >> 5; ct = item & 31; H3 = (const float*)(p.ws + OFF_H3); }
        else { const int j = item - 1024; tt = j >> 5; ct = j & 31; H3 = (const float*)(p.ws + OFF_H3) + 8192 * 64; }
#pragma unroll
        for (int k = 0; k < 8; ++k) { const int idx = tid + NT * k, r = idx >> 4, c4 = idx & 15; ph[k] = *(const f32x4*)(H3 + (size_t)(tt * 256 + r) * 64 + c4 * 4); }
#pragma unroll
        for (int k = 0; k < 2; ++k) { const int idx = tid + NT * k, j = idx >> 4, c4 = idx & 15; pw[k] = *(const f32x4*)(w4 + (size_t)j * 2048 + ct * 64 + c4 * 4); }
    };
    if ((int)blockIdx.x < 1536) fl_load(blockIdx.x);
    for (int it = blockIdx.x; it < 1536; it += gridDim.x) {
        int L, tt, ct; float* KT;
        if (it < 1024) { L = 8192; tt = it >> 5; ct = it & 31; KT = p.out; }
        else { const int j = it - 1024; L = 4096; tt = j >> 5; ct = j & 31; KT = p.out + (size_t)2048 * 8192; }
        const int t0 = tt * 256, col0 = ct * 64;
        __syncthreads();
#pragma unroll
        for (int k = 0; k < 8; ++k) {
            const int idx = tid + NT * k, r = idx >> 4, c4 = idx & 15;
            LAS float* d = Hs + r * 65 + c4 * 4; d[0] = ph[k][0]; d[1] = ph[k][1]; d[2] = ph[k][2]; d[3] = ph[k][3];
        }
#pragma unroll
        for (int k = 0; k < 2; ++k) { const int idx = tid + NT * k, j = idx >> 4, c4 = idx & 15; *(LAS f32x4*)(Ws + j * 64 + c4 * 4) = pw[k]; }
        __syncthreads();
        if (it + (int)gridDim.x < 1536) fl_load(it + gridDim.x);
        float acc[32];
#pragma unroll
        for (int i = 0; i < 32; ++i) acc[i] = 0.f;
#pragma unroll 2
        for (int j = 0; j < 64; ++j) {
            const float h = Hs[tl * 65 + j];
#pragma unroll
            for (int c8 = 0; c8 < 8; ++c8) {
                const f32x4 w = *(const LAS f32x4*)(Ws + j * 64 + cg * 32 + c8 * 4);
                acc[c8 * 4 + 0] += h * w[0]; acc[c8 * 4 + 1] += h * w[1]; acc[c8 * 4 + 2] += h * w[2]; acc[c8 * 4 + 3] += h * w[3];
            }
        }
        const float tn = (float)(t0 + tl) / (float)(L - 1);
#pragma unroll
        for (int i = 0; i < 32; ++i) {
            const int col = col0 + cg * 32 + i;
            KT[(size_t)col * L + t0 + tl] = acc[i] * __expf(-tn * fabsf(decay[col]));
        }
    }
}
__device__ __forceinline__ void phase_hyena(const Params& p, LAS unsigned char* lds) {
    for (int it = blockIdx.x; it < 1024; it += gridDim.x) {
        if (it < 512) hyena_item<8192>(p, lds, it); else hyena_item<4096>(p, lds, it - 512);
    }
}

__device__ const double ROPE_INV_REV[8] = {0.15915494309189535, 0.03086376340470123, 0.005985185712713705, 0.001160663641240061,
                                             0.00022507907903927653, 4.364795279280289e-05, 8.464330808241401e-06, 1.6414262627950345e-06};
__device__ __forceinline__ void rope_angle(int pos, int i, float& cs, float& sn) {
    double r = (double)pos * ROPE_INV_REV[i]; r -= floor(r);
    const float x = 2.0f * (float)r;
    cs = cospif(x); sn = sinpif(x);
}
__device__ __forceinline__ void phase_rope_table(const Params& p) {
    int tid = threadIdx.x; LAUNDER(tid);
    float* RT = (float*)(p.ws + OFF_ROPE);
    for (int e = blockIdx.x * NT + tid; e < 8192 * 8; e += gridDim.x * NT) {
        const int pos = e >> 3, i = e & 7; float cs, sn; rope_angle(pos, i, cs, sn);
        RT[pos * 16 + i] = cs; RT[pos * 16 + 8 + i] = sn;
    }
}
__device__ __forceinline__ void phase_attn(const Params& p, LAS unsigned char* lds) {
    int tid = threadIdx.x; LAUNDER(tid);
    const int lane = tid & 63, wv = tid >> 6, col = lane & 15, quad = lane >> 4;
    const bf16_t* QKV = (const bf16_t*)(p.ws + OFF_BIG);
    bf16_t* ATT = (bf16_t*)p.out;
    LAS bf16_t* Ks = (LAS bf16_t*)lds;
    LAS bf16_t* Vt = (LAS bf16_t*)(lds + 528 * 72 * 2);
    const float* sink = p.in[24]; const float* RT = (const float*)(p.ws + OFF_ROPE);
    constexpr float LOG2E = 1.4426950408889634f;
    for (int it = blockIdx.x; it < 1024; it += gridDim.x) {
        const int tileIdx = it >> 2, kvh = it & 3;
        int L, row0, q0;
        if (tileIdx < 128) { L = 8192; row0 = (tileIdx >> 5) * 8192; q0 = (tileIdx & 31) * 256; }
        else { const int ti = tileIdx - 128; L = 4096; row0 = 32768 + (ti >> 4) * 4096; q0 = (ti & 15) * 256; }
        const int kstart = q0 - 128;
        const bool edge = (kstart < 0) || (q0 + 256 + 144 > L);
        __syncthreads();
        {
            u32x4 k0r[5], k1r[5], vr[9]; f32x4 rc0, rc1, rs0, rs1;
            rc0 = rc1 = rs0 = rs1 = (f32x4){0.f, 0.f, 0.f, 0.f};
#pragma unroll
            for (int k = 0; k < 5; ++k) {
                const int idx = tid + NT * k; int key, ch;
                if (idx < 528) { key = idx; ch = 0; } else { const int j = idx - 528; key = j / 3; ch = 1 + (j - key * 3); }
                const int pos = kstart + key;
                k0r[k] = (u32x4){0u, 0u, 0u, 0u}; k1r[k] = k0r[k];
                if (idx < 528 * 4 && pos >= 0 && pos < L) {
                    const bf16_t* src = QKV + (size_t)(row0 + pos) * 1536 + 1024 + kvh * 64 + ch * 16;
                    k0r[k] = *(const u32x4*)src; k1r[k] = *(const u32x4*)(src + 8);
                    if (k == 0) { const float* rt = RT + pos * 16; rc0 = *(const f32x4*)rt; rc1 = *(const f32x4*)(rt + 4); rs0 = *(const f32x4*)(rt + 8); rs1 = *(const f32x4*)(rt + 12); }
                }
            }
#pragma unroll
            for (int k = 0; k < 9; ++k) {
                const int idx = tid + NT * k, c8 = idx / 528, key = idx - c8 * 528, pos = kstart + key;
                vr[k] = (u32x4){0u, 0u, 0u, 0u};
                if (idx < 528 * 8 && pos >= 0 && pos < L) vr[k] = *(const u32x4*)(QKV + (size_t)(row0 + pos) * 1536 + 1280 + kvh * 64 + c8 * 8);
            }
#pragma unroll
            for (int k = 0; k < 5; ++k) {
                const int idx = tid + NT * k;
                u32x4 v0 = k0r[k], v1 = k1r[k];
                if (k == 0 || (k == 1 && idx < 528)) {
                    if (k == 1) { const int pc = min(max(kstart + idx, 0), 8191); const float* rt = RT + pc * 16; rc0 = *(const f32x4*)rt; rc1 = *(const f32x4*)(rt + 4); rs0 = *(const f32x4*)(rt + 8); rs1 = *(const f32x4*)(rt + 12); }
                    float a[8], b[8];
#pragma unroll
                    for (int i = 0; i < 4; ++i) { a[2 * i] = __uint_as_float(v0[i] << 16); a[2 * i + 1] = __uint_as_float(v0[i] & 0xffff0000u); b[2 * i] = __uint_as_float(v1[i] << 16); b[2 * i + 1] = __uint_as_float(v1[i] & 0xffff0000u); }
#pragma unroll
                    for (int i = 0; i < 8; ++i) { const float cs = (i < 4) ? rc0[i & 3] : rc1[i & 3], sn = (i < 4) ? rs0[i & 3] : rs1[i & 3]; const float na = a[i] * cs - b[i] * sn, nb = b[i] * cs + a[i] * sn; a[i] = na; b[i] = nb; }
#pragma unroll
                    for (int i = 0; i < 4; ++i) { v0[i] = pk2(a[2 * i], a[2 * i + 1]); v1[i] = pk2(b[2 * i], b[2 * i + 1]); }
                }
                int key, ch;
                if (idx < 528) { key = idx; ch = 0; } else { const int j = idx - 528; key = j / 3; ch = 1 + (j - key * 3); }
                if (idx < 528 * 4) { *(LAS u32x4*)(Ks + key * 72 + ch * 16) = v0; *(LAS u32x4*)(Ks + key * 72 + ch * 16 + 8) = v1; }
            }
#pragma unroll
            for (int k = 0; k < 9; ++k) {
                const int idx = tid + NT * k, c8 = idx / 528, key = idx - c8 * 528;
                if (idx < 528 * 8) {
                    const u32x4 v = vr[k];
#pragma unroll
                    for (int i = 0; i < 4; ++i) { Vt[(c8 * 8 + 2 * i) * 536 + key] = (bf16_t)(v[i] & 0xffffu); Vt[(c8 * 8 + 2 * i + 1) * 536 + key] = (bf16_t)(v[i] >> 16); }
                }
            }
        }
        __syncthreads();
#pragma unroll 1
        for (int bi = 0; bi < 8; ++bi) {
            const int blk = wv + 8 * bi, g = blk >> 4, qt = blk & 15, h = kvh * 4 + g, qa = q0 + qt * 16;
            const int qpos = qa + col;
            bf16x8 qf[2];
            {
                const bf16_t* qsrc = QKV + (size_t)(row0 + qpos) * 1536 + h * 64;
                u32x4 r0 = *(const u32x4*)(qsrc + quad * 8), r1 = *(const u32x4*)(qsrc + 32 + quad * 8);
                if (quad < 2) {
                    const u32x4 ra = *(const u32x4*)(qsrc), rb = *(const u32x4*)(qsrc + 8);
                    float a[8], b[8];
#pragma unroll
                    for (int i = 0; i < 4; ++i) { a[2 * i] = __uint_as_float(ra[i] << 16); a[2 * i + 1] = __uint_as_float(ra[i] & 0xffff0000u); b[2 * i] = __uint_as_float(rb[i] << 16); b[2 * i + 1] = __uint_as_float(rb[i] & 0xffff0000u); }
                    float o[8];
                    const float* rt = RT + qpos * 16; const f32x4 c0 = *(const f32x4*)rt, c1 = *(const f32x4*)(rt + 4), s0 = *(const f32x4*)(rt + 8), s1 = *(const f32x4*)(rt + 12);
#pragma unroll
                    for (int i = 0; i < 8; ++i) { const float cs = (i < 4) ? c0[i & 3] : c1[i & 3], sn = (i < 4) ? s0[i & 3] : s1[i & 3]; o[i] = (quad == 0) ? (a[i] * cs - b[i] * sn) : (b[i] * cs + a[i] * sn); }
#pragma unroll
                    for (int i = 0; i < 4; ++i) r0[i] = pk2(o[2 * i], o[2 * i + 1]);
                }
                qf[0] = __builtin_bit_cast(bf16x8, r0); qf[1] = __builtin_bit_cast(bf16x8, r1);
            }
            const int kk0 = qt * 16;
            const float sk2 = sink[h] * LOG2E;
            f32x4 sc[18];
            float mx = -1e30f;
            sc[17] = (f32x4){-1e30f, -1e30f, -1e30f, -1e30f};
            bf16x8 kfc[2], kfn[2];
            f32x4 accp = (f32x4){0.f, 0.f, 0.f, 0.f};
#pragma unroll
            for (int ks = 0; ks < 2; ++ks) kfc[ks] = *(const LAS bf16x8*)(Ks + (kk0 + col) * 72 + ks * 32 + quad * 8);
#pragma unroll
            for (int j = 0; j <= 17; ++j) {
                if (j + 1 < 17) {
#pragma unroll
                    for (int ks = 0; ks < 2; ++ks) kfn[ks] = *(const LAS bf16x8*)(Ks + (kk0 + 16 * (j + 1) + col) * 72 + ks * 32 + quad * 8);
                }
                f32x4 acc = (f32x4){0.f, 0.f, 0.f, 0.f};
                if (j < 17) {
                    acc = __builtin_amdgcn_mfma_f32_16x16x32_bf16(kfc[0], qf[0], acc, 0, 0, 0);
                    acc = __builtin_amdgcn_mfma_f32_16x16x32_bf16(kfc[1], qf[1], acc, 0, 0, 0);
                }
                if (j >= 1) {
                    const int jj = j - 1;
                    if (jj >= 1 && jj <= 15 && !edge) {
#pragma unroll
                        for (int i = 0; i < 4; ++i) { const float tv = accp[i] * (0.125f * LOG2E); accp[i] = tv; mx = fmaxf(mx, tv); }
                    } else {
#pragma unroll
                        for (int i = 0; i < 4; ++i) {
                            const int rel = -128 + 16 * jj + 4 * quad + i - col, kpos = qpos + rel;
                            const bool valid = (rel >= -128) && (rel <= 128) && (kpos >= 0) && (kpos < L);
                            const float tv = valid ? accp[i] * (0.125f * LOG2E) : -1e30f;
                            accp[i] = tv; mx = fmaxf(mx, tv);
                        }
                    }
                    sc[jj] = accp;
                }
                accp = acc; kfc[0] = kfn[0]; kfc[1] = kfn[1];
                __builtin_amdgcn_sched_barrier(0);
            }
            mx = fmaxf(mx, __shfl_xor(mx, 16, 64)); mx = fmaxf(mx, __shfl_xor(mx, 32, 64));
            mx = fmaxf(mx, sk2);
            float sum = 0.f;
#pragma unroll
            for (int j = 0; j < 18; ++j)
#pragma unroll
                for (int i = 0; i < 4; ++i) { const float pv = __builtin_amdgcn_exp2f(sc[j][i] - mx); sc[j][i] = pv; sum += pv; }
            sum += __shfl_xor(sum, 16, 64); sum += __shfl_xor(sum, 32, 64);
            const float rden = 1.0f / (sum + __builtin_amdgcn_exp2f(sk2 - mx));
            f32x4 oacc[4];
#pragma unroll
            for (int dt = 0; dt < 4; ++dt) oacc[dt] = (f32x4){0.f, 0.f, 0.f, 0.f};
            u32x4 vfc[4], vfn[4];
#pragma unroll
            for (int dt = 0; dt < 4; ++dt) {
                const LAS bf16_t* vp = Vt + (dt * 16 + col) * 536 + kk0 + 4 * quad;
                const u32x2 lo = *(const LAS u32x2*)vp, hi = *(const LAS u32x2*)(vp + 16);
                vfc[dt].x = lo.x; vfc[dt].y = lo.y; vfc[dt].z = hi.x; vfc[dt].w = hi.y;
            }
#pragma unroll
            for (int gI = 0; gI < 9; ++gI) {
                if (gI + 1 < 9) {
#pragma unroll
                    for (int dt = 0; dt < 4; ++dt) {
                        const LAS bf16_t* vp = Vt + (dt * 16 + col) * 536 + kk0 + 32 * (gI + 1) + 4 * quad;
                        const u32x2 lo = *(const LAS u32x2*)vp, hi = *(const LAS u32x2*)(vp + 16);
                        vfn[dt].x = lo.x; vfn[dt].y = lo.y; vfn[dt].z = hi.x; vfn[dt].w = hi.y;
                    }
                }
                u32x4 pb; pb.x = pk2(sc[2 * gI][0], sc[2 * gI][1]); pb.y = pk2(sc[2 * gI][2], sc[2 * gI][3]); pb.z = pk2(sc[2 * gI + 1][0], sc[2 * gI + 1][1]); pb.w = pk2(sc[2 * gI + 1][2], sc[2 * gI + 1][3]);
                const bf16x8 pf = __builtin_bit_cast(bf16x8, pb);
#pragma unroll
                for (int dt = 0; dt < 4; ++dt) oacc[dt] = __builtin_amdgcn_mfma_f32_16x16x32_bf16(__builtin_bit_cast(bf16x8, vfc[dt]), pf, oacc[dt], 0, 0, 0);
#pragma unroll
                for (int dt = 0; dt < 4; ++dt) vfc[dt] = vfn[dt];
                __builtin_amdgcn_sched_barrier(0);
            }
            bf16_t* op = ATT + (size_t)(row0 + qpos) * 1024 + h * 64 + 4 * quad;
#pragma unroll
            for (int dt = 0; dt < 4; ++dt) { u32x2 o; o.x = pk2(oacc[dt][0] * rden, oacc[dt][1] * rden); o.y = pk2(oacc[dt][2] * rden, oacc[dt][3] * rden); *(u32x2*)(op + dt * 16) = o; }
        }
    }
}

#define XB_TMO      128
#define XB_XCNT(j)  (256  + 64 * (j))
#define XB_XSUB(j)  (1280 + 64 * (j))
#define XB_XGEN(j)  (2304 + 64 * (j))
#define XB_TOP      3328
#define XB_TOPGEN   3392
#define XCD_BAR_WORDS 3456
#define XB_SPIN_CAP (1u << 22)
__device__ __forceinline__ unsigned xb_ld(unsigned* p)              { return __hip_atomic_load(p, __ATOMIC_RELAXED, __HIP_MEMORY_SCOPE_AGENT); }
__device__ __forceinline__ unsigned xb_add(unsigned* p, unsigned v) { return __hip_atomic_fetch_add(p, v, __ATOMIC_RELAXED, __HIP_MEMORY_SCOPE_AGENT); }
__device__ __forceinline__ unsigned xb_xcc_id() { return (unsigned)__builtin_amdgcn_s_getreg((3 << 11) | 20) & 0xFu; }
#define XB_SPIN(cond, bar) do { unsigned _sp = 0; while (cond) { __builtin_amdgcn_s_sleep(1); \
    if ((++_sp & 255u) == 0u) { if (xb_ld(&(bar)[XB_TMO])) break; if (_sp > XB_SPIN_CAP) { atomicAdd(&(bar)[XB_TMO], 1u); break; } } } } while (0)
struct XcdBarrier { unsigned* bar; unsigned x; volatile LAS unsigned* st; };
__device__ __forceinline__ XcdBarrier xcd_barrier_post(unsigned* bar, volatile LAS unsigned* st) {
    XcdBarrier b; b.bar = bar; b.x = xb_xcc_id(); b.st = st;
    if (threadIdx.x == 0) (void)xb_add(&bar[XB_XCNT(b.x)], 1u);
    return b;
}
__device__ __forceinline__ void xcd_barrier_complete(unsigned* bar, unsigned x, unsigned& nloc, unsigned& nx) {
    const unsigned G = gridDim.x * gridDim.y * gridDim.z;
    unsigned sum, cnt, mine, sp = 0u;
    for (;;) {
        sum = 0u; cnt = 0u; mine = 0u;
#pragma unroll
        for (unsigned j = 0; j < 16; ++j) { const unsigned c = xb_ld(&bar[XB_XCNT(j)]); sum += c; cnt += (c > 0u) ? 1u : 0u; mine = (j == x) ? c : mine; }
        if (sum == G) break;
        __builtin_amdgcn_s_sleep(1);
        if ((++sp & 255u) == 0u) { if (xb_ld(&bar[XB_TMO])) break; if (sp > XB_SPIN_CAP) { atomicAdd(&bar[XB_TMO], 1u); break; } }
    }
    nloc = mine > 0u ? mine : 1u; nx = cnt > 0u ? cnt : 1u;
}
__device__ __forceinline__ void xcd_barrier(const XcdBarrier& b) {
    asm volatile("s_waitcnt vmcnt(0)" ::: "memory");
    __syncthreads();
    if (threadIdx.x == 0) {
        unsigned* bar = b.bar;
        __builtin_amdgcn_s_waitcnt(0);
        unsigned nloc = b.st[0], nx = b.st[1];
        if (nloc == 0u) { xcd_barrier_complete(bar, b.x, nloc, nx); b.st[0] = nloc; b.st[1] = nx; }
        const unsigned old = xb_add(&bar[XB_XSUB(b.x)], 1u);
        const unsigned gen = old / nloc;
        if (old + 1u == (gen + 1u) * nloc) {
            __builtin_amdgcn_fence(__ATOMIC_RELEASE, "agent");
            asm volatile("s_waitcnt vmcnt(0)" ::: "memory");
            const unsigned og = xb_add(&bar[XB_TOP], 1u);
            const unsigned tg = og / nx;
            if (og + 1u == (tg + 1u) * nx) xb_add(&bar[XB_TOPGEN], 1u);
            else XB_SPIN(xb_ld(&bar[XB_TOPGEN]) == tg, bar);
            __builtin_amdgcn_fence(__ATOMIC_ACQUIRE, "agent");
            xb_add(&bar[XB_XGEN(b.x)], 1u);
            asm volatile("s_waitcnt vmcnt(0)" ::: "memory");
        } else {
            XB_SPIN(xb_ld(&bar[XB_XGEN(b.x)]) == gen, bar);
            __builtin_amdgcn_fence(__ATOMIC_ACQUIRE, "agent");
            asm volatile("s_waitcnt vmcnt(0)" ::: "memory");
        }
    }
    __syncthreads();
}

constexpr int NPH = 19;
__global__ void __launch_bounds__(NT) mk_fwd(Params p) {
    extern __shared__ __attribute__((aligned(16))) unsigned char lds_raw[];
    LAS unsigned char* lds = (LAS unsigned char*)lds_raw;
    volatile LAS unsigned* xbst = (volatile LAS unsigned*)(lds + LDS_BYTES - 16);
    if (threadIdx.x == 0) { xbst[0] = 0u; xbst[1] = 0u; }
    __syncthreads();
    XcdBarrier xb{};
    if (p.ph_hi - p.ph_lo > 1) xb = xcd_barrier_post((unsigned*)(p.ws + OFF_BAR), xbst);
    bf16_t* R0 = (bf16_t*)(p.ws + OFF_HN);
    bf16_t* R1 = (bf16_t*)(p.ws + OFF_BIG);
    bf16_t* DO = (bf16_t*)p.out;
    float* SS = (float*)(p.ws + OFF_SS);
#if PROBE_MASK
    unsigned long long pr_acc = 0ull;
#endif
    for (int ph = p.ph_lo; ph < p.ph_hi; ++ph) {
#if PROBE_MASK
        const unsigned long long pr_t0 = __builtin_amdgcn_s_memrealtime();
#endif
        int kind = 0;
        pg8::Gemm g{}; pg8::EpiBf eb{}; pg8::EpiRes er{};
        if (ph == 0) kind = 10;
        else if (ph == 1) { kind = 2; g = pg8::Gemm{R0, (bf16_t*)(p.ws + OFF_WIN), NTOK, 2560, 1024}; eb = pg8::EpiBf{2, DO, 512, DO + (size_t)NTOK * 512, SS, 0}; }
        else if (ph == 2) kind = 11;
        else if (ph == 3) kind = 16;
        else if (ph == 4) kind = 12;
        else if (ph == 5) kind = 13;
        else if (ph == 6) { kind = 3; g = pg8::Gemm{R0, (bf16_t*)(p.ws + OFF_WOUT), NTOK, 1024, 1024}; er = pg8::EpiRes{p.in[0], p.in[1], nullptr, R1, 0, SS + 65536}; }
        else if ((ph >= 7 && ph <= 10) || (ph >= 14 && ph <= 17)) {
            const int layer = (ph >= 14), i = ph - (layer ? 14 : 7), h = i >> 1;
            if ((i & 1) == 0) { kind = 2; g = pg8::Gemm{R1 + (size_t)h * 32768 * 1024, (bf16_t*)(p.ws + OFF_WUP) + (size_t)layer * N_WFF, 32768, 4096, 1024};
                eb = pg8::EpiBf{1, DO, 4096, nullptr, SS + (layer ? 3 : 1) * 65536, h * 32768}; }
            else { kind = 3; g = pg8::Gemm{DO, (bf16_t*)(p.ws + OFF_WDN) + (size_t)layer * N_WFF, 32768, 1024, 4096};
                er = pg8::EpiRes{nullptr, nullptr, R1, layer ? R1 : R0, h * 32768, SS + (layer ? 4 : 2) * 65536}; }
        }
        else if (ph == 11) { kind = 2; g = pg8::Gemm{R0, (bf16_t*)(p.ws + OFF_WQKV), NTOK, 1536, 1024}; eb = pg8::EpiBf{0, R1, 1536, nullptr, SS + 2 * 65536, 0}; }
        else if (ph == 12) kind = 14;
        else if (ph == 13) { kind = 3; g = pg8::Gemm{DO, (bf16_t*)(p.ws + OFF_WO), NTOK, 1024, 1024}; er = pg8::EpiRes{nullptr, nullptr, R0, R1, 0, SS + 3 * 65536}; }
        else kind = 15;
        if (kind == 2) { pg8::StaticOrder S; S.init(g.M, g.N, gridDim.x, blockIdx.x); pg8::gemm_phase<pg8::EpiBf>(lds, g, S, eb); }
        else if (kind == 3) { pg8::StaticOrder S; S.init(g.M, g.N, gridDim.x, blockIdx.x); pg8::gemm_phase<pg8::EpiRes>(lds, g, S, er); }
        else if (kind == 10) { phase_weights(p, (LAS float*)lds); phase_filter_hidden(p, (LAS float*)lds); phase_rope_table(p); phase_prep_x(p); }
        else if (kind == 11) { phase_conformer(p, lds); phase_shortconv_T(p, (LAS float*)lds); }
        else if (kind == 12) phase_hyena(p, lds);
        else if (kind == 13) phase_zT(p, (LAS float*)lds);
        else if (kind == 14) phase_attn(p, lds);
        else if (kind == 15) phase_final_norm(p);
        else if (kind == 16) phase_filters(p, lds);
        if (ph + 1 < p.ph_hi) { if (p.ph_hi > 1000) cg::this_grid().sync();   xcd_barrier(xb); }
#if PROBE_MASK
        if ((PROBE_MASK >> ph) & 1u) pr_acc += __builtin_amdgcn_s_memrealtime() - pr_t0;
#endif
    }
#if PROBE_MASK
    if (blockIdx.x == 0 && threadIdx.x == 0) { const unsigned long long t1 = __builtin_amdgcn_s_memrealtime(); while (__builtin_amdgcn_s_memrealtime() - t1 < PROBE_MULT * pr_acc) __builtin_amdgcn_s_sleep(8); }
#endif
}

extern "C" void kernel_launch(void* const* d_in, const int* in_sizes, int n_in, void* d_out, int out_size, void* d_ws, size_t ws_size, hipStream_t stream) {
    static int grid = 0;
    if (grid == 0) {
        if (n_in != 28 || ws_size < WS_END) { fprintf(stderr, "kernel_launch: unexpected n_in %d / ws_size %zu (need %zu)\n", n_in, ws_size, (size_t)WS_END); grid = -1; return; }
        int dev = 0, cus = 0, per_cu = 0;
        hipGetDevice(&dev); hipDeviceGetAttribute(&cus, hipDeviceAttributeMultiprocessorCount, dev);
        if (hipFuncSetAttribute((const void*)mk_fwd, hipFuncAttributeMaxDynamicSharedMemorySize, LDS_BYTES) != hipSuccess) { fprintf(stderr, "kernel_launch: hipFuncSetAttribute failed\n"); grid = -1; return; }
        hipOccupancyMaxActiveBlocksPerMultiprocessor(&per_cu, (const void*)mk_fwd, NT, LDS_BYTES);
        if (per_cu < 1) { fprintf(stderr, "kernel_launch: occupancy query says %d blocks per CU\n", per_cu); per_cu = 1; }
        (void)hipGetLastError();
        grid = cus > 256 ? 256 : cus;
    }
    if (grid < 0) return;
    Params p{};
    for (int i = 0; i < 28; ++i) p.in[i] = (const float*)d_in[i];
    p.out = (float*)d_out; p.ws = (unsigned char*)d_ws;
#if MK_MULTI
    for (int ph = 0; ph < NPH; ++ph) {
        p.ph_lo = ph; p.ph_hi = ph + 1;
        hipLaunchKernelGGL(mk_fwd, dim3(grid), dim3(NT), LDS_BYTES, stream, p);
    }
#else
    p.ph_lo = 0; p.ph_hi = NPH;
    if (hipMemsetAsync((char*)d_ws + OFF_BAR, 0, XCD_BAR_BYTES, stream) != hipSuccess) { fprintf(stderr, "kernel_launch: memset of barrier words failed\n"); return; }
    void* args[] = {&p};
    hipError_t e = hipLaunchCooperativeKernel((const void*)mk_fwd, dim3(grid), dim3(NT), args, LDS_BYTES, stream);
    if (e != hipSuccess) fprintf(stderr, "cooperative launch failed: %s (grid %d)\n", hipGetErrorString(e), grid);
#endif
}
#endif
```

```cpp
#include <hip/hip_runtime.h>
#include <hip/hip_cooperative_groups.h>
#include <cstdio>
namespace cg = cooperative_groups;

#ifndef PROBE_MASK
#define PROBE_MASK 0u
#endif
#define PROBE_MULT 4
#ifndef MK_MULTI
#define MK_MULTI 0
#endif

#define LAS __attribute__((address_space(3)))
#if defined(__HIP_DEVICE_COMPILE__)
#define LAUNDER(x) asm volatile("" : "+v"(x))
#else
#define LAUNDER(x)
#endif
typedef unsigned short bf16_t;
typedef short bf16x8 __attribute__((ext_vector_type(8)));
typedef short bf16x4 __attribute__((ext_vector_type(4)));
typedef float f32x4 __attribute__((ext_vector_type(4)));
typedef unsigned u32x4 __attribute__((ext_vector_type(4)));
typedef unsigned u32x2 __attribute__((ext_vector_type(2)));

constexpr int NT = 512;
constexpr int NTOK = 65536;
constexpr int DM = 1024;
constexpr int LDS_X_BYTES = (16384 + 1024) * 8;
constexpr int LDS_BYTES = 147456;
constexpr size_t XCD_BAR_BYTES = 3456 * 4;

constexpr size_t N_WIN = 2560ull * 1024, N_WSQ = 1024ull * 1024, N_WQKV = 1536ull * 1024, N_WFF = 4096ull * 1024;
constexpr size_t OFF_WIN = 0;
constexpr size_t OFF_WOUT = OFF_WIN + N_WIN * 2;
constexpr size_t OFF_WQKV = OFF_WOUT + N_WSQ * 2;
constexpr size_t OFF_WO = OFF_WQKV + N_WQKV * 2;
constexpr size_t OFF_WUP = OFF_WO + N_WSQ * 2;
constexpr size_t OFF_WDN = OFF_WUP + 2 * N_WFF * 2;
constexpr size_t OFF_H3 = OFF_WDN + 2 * N_WFF * 2;
constexpr size_t OFF_HN = OFF_H3 + 12288ull * 64 * 4;
constexpr size_t OFF_BIG = OFF_HN + (size_t)NTOK * 1024 * 2;
constexpr size_t OFF_SPEC = OFF_BIG + (size_t)NTOK * 1536 * 2;
constexpr size_t OFF_ZST = OFF_BIG + 268435456ull;
constexpr size_t OFF_BAR = OFF_ZST + 256ull * 8192 * 8;
constexpr size_t OFF_SS = OFF_BAR + 16384;
constexpr size_t OFF_ROPE = OFF_SS + 5ull * 65536 * 4;
constexpr size_t WS_END = OFF_ROPE + 8192ull * 16 * 4;

struct Params {
    const float* in[28];
    float* out;
    unsigned char* ws;
    int ph_lo, ph_hi;
};

__device__ __forceinline__ float bf2f(bf16_t b) { return __uint_as_float(((unsigned)b) << 16); }
__device__ __forceinline__ bf16_t f2bf(float f) { unsigned u = __float_as_uint(f); u += 0x7FFFu + ((u >> 16) & 1u); return (bf16_t)(u >> 16); }
__device__ __forceinline__ unsigned pk2(float lo, float hi) { unsigned r; asm("v_cvt_pk_bf16_f32 %0, %1, %2" : "=v"(r) : "v"(lo), "v"(hi)); return r; }
__device__ __forceinline__ float wave_sum(float v) {
#pragma unroll
    for (int o = 32; o >= 1; o >>= 1) v += __shfl_xor(v, o, 64);
    return v;
}
__device__ __forceinline__ void seq_of_row(int row, int& L, int& row0) {
    if (row < 32768) { L = 8192; row0 = row & ~8191; } else { L = 4096; row0 = 32768 + ((row - 32768) & ~4095); }
}

namespace pg8 {
constexpr int BM = 256, BK = 64, HALF = 128, HTB = HALF * BK * 2, STAGE_BYTES = 8 * HTB, NXCD = 8, WGM = 8;
__device__ __forceinline__ int lds_byte(int r, int c) { const int st = (r >> 4) * 2 + (c >> 5), rr = r & 15, cc = c & 31, ob = rr * 64 + cc * 2; return st * 1024 + (ob ^ (((ob >> 9) & 1) << 5)); }
__device__ __forceinline__ void stage_rc(int b, int& R, int& C) { const int st = b / 1024, sb = b % 1024, swz = sb ^ (((sb >> 9) & 1) << 5); R = (st >> 1) * 16 + swz / 64; C = (st & 1) * 32 + (swz % 64) / 2; }
__device__ __forceinline__ int perm32(int rho) { const int n = rho >> 4, i = rho & 15; return 8 * (i >> 2) + 4 * n + (i & 3); }
struct Unit { int pm, pn; };
struct Gemm { const bf16_t* A; const bf16_t* Bt; int M, N, K; };
struct StaticOrder {
    int nM, nN, nwg, G, c;
    __device__ __forceinline__ void init(int M, int N, int G_, int c_) { nM = M / BM; nN = N / BM; nwg = nM * nN; G = G_; c = c_; }
    __device__ __forceinline__ bool next(int i, Unit& u) const {
        const long L = (long)i * G + c; if (L >= nwg) return false;
        int wgid = (int)L; { const int q = nwg / NXCD, r = nwg % NXCD, xcd = wgid % NXCD, off = wgid / NXCD; wgid = (xcd < r ? xcd * (q + 1) : r * (q + 1) + (xcd - r) * q) + off; }
        const int nig = WGM * nN, gid = wgid / nig, fm = gid * WGM, gsz = (nM - fm) < WGM ? (nM - fm) : WGM;
        u.pm = fm + ((wgid % nig) % gsz); u.pn = (wgid % nig) / gsz; return true;
    }
};

struct EpiBf {
    static constexpr bool PERM = true;
    int mode; bf16_t* O; int ldc; bf16_t* O2; const float* ss; int ss_off;
    static constexpr int NPRE = 8;
    __device__ __forceinline__ void prefetch(float (&sv)[8], const Unit& u, int wr, int fr) const {
        const int row0 = ss_off + u.pm * BM + wr * 64 + fr;
#pragma unroll
        for (int ai = 0; ai < 2; ++ai)
#pragma unroll
            for (int m = 0; m < 4; ++m) sv[ai * 4 + m] = ss[row0 + ai * HALF + m * 16];
    }
    __device__ __forceinline__ void operator()(const f32x4 (&acc)[2][2][4][2], const float (&sv)[8], const Unit& u, int wr, int wc, int fr, int fq) const {
        const int row0 = u.pm * BM + wr * 64 + fr, colt = u.pn * BM;
#pragma unroll
        for (int ai = 0; ai < 2; ++ai)
#pragma unroll
            for (int m = 0; m < 4; ++m) {
                const size_t row = (size_t)(row0 + ai * HALF + m * 16);
                const float rstd = rsqrtf(sv[ai * 4 + m] * (1.0f / 1024.0f) + 1e-5f);
#pragma unroll
                for (int bj = 0; bj < 2; ++bj) {
                    const int c0 = colt + bj * HALF + wc * 32 + 8 * fq;
                    f32x4 v0 = acc[ai][bj][m][0] * rstd, v1 = acc[ai][bj][m][1] * rstd;
                    if (mode == 2) {
                        if (colt < 1024) {
                            float h[4];
#pragma unroll
                            for (int i = 0; i < 4; ++i) h[i] = v0[i] * __builtin_amdgcn_rcpf(1.0f + __expf(-v1[i]));
                            u32x2 o; o.x = pk2(h[0], h[1]); o.y = pk2(h[2], h[3]);
                            *(u32x2*)(O + row * 512 + (c0 >> 1)) = o;
                        } else {
                            u32x4 o; o.x = pk2(v0[0], v0[1]); o.y = pk2(v0[2], v0[3]); o.z = pk2(v1[0], v1[1]); o.w = pk2(v1[2], v1[3]);
                            *(u32x4*)(O2 + row * 1536 + (c0 - 1024)) = o;
                        }
                    } else {
                        if (mode == 1) {
#pragma unroll
                            for (int i = 0; i < 4; ++i) { float a = fmaxf(v0[i], 0.f), b = fmaxf(v1[i], 0.f); v0[i] = a * a; v1[i] = b * b; }
                        }
                        u32x4 o; o.x = pk2(v0[0], v0[1]); o.y = pk2(v0[2], v0[3]); o.z = pk2(v1[0], v1[1]); o.w = pk2(v1[2], v1[3]);
                        *(u32x4*)(O + row * ldc + c0) = o;
                    }
                }
            }
    }
};
struct EpiRes {
    static constexpr bool PERM = true;
    const float* res_f0; const float* res_f1; const bf16_t* res_b; bf16_t* xout; int row_off; float* ss;
    __device__ __forceinline__ void prefetch(float (&)[8], const Unit&, int, int) const {}
    __device__ __forceinline__ void operator()(const f32x4 (&acc)[2][2][4][2], const float (&)[8], const Unit& u, int wr, int wc, int fr, int fq) const {
        const int row0 = row_off + u.pm * BM + wr * 64 + fr, col0 = u.pn * BM + wc * 32 + 8 * fq;
#pragma unroll
        for (int ai = 0; ai < 2; ++ai) {
            f32x4 r0[4][2], r1[4][2];
            if (res_b) {
                u32x4 t[4][2];
#pragma unroll
                for (int m = 0; m < 4; ++m)
#pragma unroll
                    for (int bj = 0; bj < 2; ++bj) t[m][bj] = *(const u32x4*)(res_b + (size_t)(row0 + ai * HALF + m * 16) * 1024 + col0 + bj * HALF);
#pragma unroll
                for (int m = 0; m < 4; ++m)
#pragma unroll
                    for (int bj = 0; bj < 2; ++bj) {
                        const u32x4 q = t[m][bj];
                        r0[m][bj][0] = __uint_as_float(q.x << 16); r0[m][bj][1] = __uint_as_float(q.x & 0xffff0000u); r0[m][bj][2] = __uint_as_float(q.y << 16); r0[m][bj][3] = __uint_as_float(q.y & 0xffff0000u);
                        r1[m][bj][0] = __uint_as_float(q.z << 16); r1[m][bj][1] = __uint_as_float(q.z & 0xffff0000u); r1[m][bj][2] = __uint_as_float(q.w << 16); r1[m][bj][3] = __uint_as_float(q.w & 0xffff0000u);
                    }
            } else {
#pragma unroll
                for (int m = 0; m < 4; ++m) {
                    const int row = row0 + ai * HALF + m * 16;
                    const float* rp = (row < 32768) ? res_f0 + (size_t)row * 1024 : res_f1 + (size_t)(row - 32768) * 1024;
#pragma unroll
                    for (int bj = 0; bj < 2; ++bj) { r0[m][bj] = *(const f32x4*)(rp + col0 + bj * HALF); r1[m][bj] = *(const f32x4*)(rp + col0 + bj * HALF + 4); }
                }
            }
#pragma unroll
            for (int m = 0; m < 4; ++m) {
                const int row = row0 + ai * HALF + m * 16;
                float part = 0.f;
#pragma unroll
                for (int bj = 0; bj < 2; ++bj) {
                    const f32x4 v0 = r0[m][bj] + acc[ai][bj][m][0], v1 = r1[m][bj] + acc[ai][bj][m][1];
                    part += v0[0] * v0[0] + v0[1] * v0[1] + v0[2] * v0[2] + v0[3] * v0[3] + v1[0] * v1[0] + v1[1] * v1[1] + v1[2] * v1[2] + v1[3] * v1[3];
                    u32x4 o; o.x = pk2(v0[0], v0[1]); o.y = pk2(v0[2], v0[3]); o.z = pk2(v1[0], v1[1]); o.w = pk2(v1[2], v1[3]);
                    *(u32x4*)(xout + (size_t)row * 1024 + col0 + bj * HALF) = o;
                }
                part += __shfl_xor(part, 16, 64); part += __shfl_xor(part, 32, 64);
                if (fq == 0) atomicAdd(ss + row, part);
            }
        }
    }
};

template <class Epi>
__device__ __forceinline__ void gemm_phase(LAS unsigned char* lds, const Gemm g, const StaticOrder& S, const Epi& E) {
    int tid = threadIdx.x; LAUNDER(tid);
    const int wid = __builtin_amdgcn_readfirstlane(tid >> 6), lane = tid & 63, wr = wid >> 2, wc = wid & 3, fr = lane & 15, fq = lane >> 4;
    const int K = g.K, nt = K / BK;
    unsigned voffA[2], voffB[2];
#pragma unroll
    for (int i = 0; i < 2; ++i) { int R, C; stage_rc(tid * 16 + i * 8192, R, C); const int Rb = Epi::PERM ? ((R & ~31) + perm32(R & 31)) : R;
        voffA[i] = (unsigned)(R * K + C) * 2u; voffB[i] = (unsigned)(Rb * K + C) * 2u; }
    const size_t kstep = (size_t)(BK * 2);
    const size_t hstep = (size_t)HALF * K * 2;
    const size_t tstep = 2 * hstep;
    const unsigned ldsw = (unsigned)wid * 1024u;
    const int aoff = lds_byte(wr * 64 + fr, fq * 8), boff = lds_byte(wc * 32 + fr, fq * 8);
#define PG8_SA(b, h) (((b) * 2 + (h)) * HTB)
#define PG8_SB(b, h) ((4 + (b) * 2 + (h)) * HTB)
#define PG8_STAGE(bufoff, gbase, voff) do { _Pragma("unroll") for (int _i = 0; _i < 2; ++_i) \
        __builtin_amdgcn_global_load_lds((const unsigned*)((const char*)(gbase) + (voff)[_i]), (LAS unsigned*)(lds + (bufoff) + ldsw + _i * 8192), 16, 0, 0); } while (0)
#define PG8_LDA(dst, b, h) do { _Pragma("unroll") for (int m = 0; m < 4; ++m) _Pragma("unroll") for (int k = 0; k < 2; ++k) dst[m][k] = *(const LAS bf16x8*)(lds + PG8_SA(b, h) + aoff + m * 2048 + k * 1024); } while (0)
#define PG8_LDB(dst, b, h) do { _Pragma("unroll") for (int n = 0; n < 2; ++n) _Pragma("unroll") for (int k = 0; k < 2; ++k) dst[n][k] = *(const LAS bf16x8*)(lds + PG8_SB(b, h) + boff + n * 2048 + k * 1024); } while (0)
#define PG8_MMA(ai, bj, At, Bt) do { __builtin_amdgcn_s_setprio(1); _Pragma("unroll") for (int m = 0; m < 4; ++m) _Pragma("unroll") for (int n = 0; n < 2; ++n) _Pragma("unroll") for (int k = 0; k < 2; ++k) \
        acc[ai][bj][m][n] = __builtin_amdgcn_mfma_f32_16x16x32_bf16(Bt[n][k], At[m][k], acc[ai][bj][m][n], 0, 0, 0); __builtin_amdgcn_s_setprio(0); } while (0)
#define PG8_WAIT_V(n) asm volatile("s_waitcnt vmcnt(" #n ")" ::: "memory")
#define PG8_WAIT_L(n) asm volatile("s_waitcnt lgkmcnt(" #n ")" ::: "memory")
#define PG8_BAR __builtin_amdgcn_s_barrier()
#define PG8_SCHED __builtin_amdgcn_sched_barrier(0)
    Unit cur, nxt; int ui = 0;
    if (!S.next(0, cur)) return;
    f32x4 acc[2][2][4][2];
#pragma unroll
    for (int a = 0; a < 2; ++a)
#pragma unroll
        for (int b = 0; b < 2; ++b)
#pragma unroll
            for (int m = 0; m < 4; ++m)
#pragma unroll
                for (int n = 0; n < 2; ++n) acc[a][b][m][n] = (f32x4){0.f, 0.f, 0.f, 0.f};
    bf16x8 At[4][2], B0[2][2], B1[2][2];
    const char* cA = (const char*)g.A + (size_t)cur.pm * tstep; const char* cB = (const char*)g.Bt + (size_t)cur.pn * tstep;
    float sv[8] = {0.f, 0.f, 0.f, 0.f, 0.f, 0.f, 0.f, 0.f};
    E.prefetch(sv, cur, wr, fr);
    PG8_STAGE(PG8_SB(0, 0), cB, voffB); PG8_STAGE(PG8_SA(0, 0), cA, voffA); PG8_STAGE(PG8_SB(0, 1), cB + hstep, voffB); PG8_STAGE(PG8_SA(0, 1), cA + hstep, voffA);
    if (wr == 1) PG8_BAR;
    PG8_WAIT_V(4); PG8_BAR;
    PG8_STAGE(PG8_SB(1, 0), cB + kstep, voffB); PG8_STAGE(PG8_SA(1, 0), cA + kstep, voffA); PG8_STAGE(PG8_SB(1, 1), cB + hstep + kstep, voffB);
    PG8_WAIT_V(6); PG8_BAR;
    for (;;) {
        const bool has_next = S.next(ui + 1, nxt);
        const char* nA = has_next ? (const char*)g.A + (size_t)nxt.pm * tstep : cA; const char* nB = has_next ? (const char*)g.Bt + (size_t)nxt.pn * tstep : cB;
        for (int t = 0; t < nt; t += 2) {
            const bool last = (t == nt - 2);
            const char* a1 = cA + (size_t)(t + 1) * kstep;
            const char* a2 = last ? nA : cA + (size_t)(t + 2) * kstep; const char* b2 = last ? nB : cB + (size_t)(t + 2) * kstep;
            const char* a3 = a2 + kstep; const char* b3 = b2 + kstep;
            PG8_LDB(B0, 0, 0); PG8_SCHED; PG8_LDA(At, 0, 0); PG8_STAGE(PG8_SA(1, 1), a1 + hstep, voffA);
            PG8_WAIT_L(8); PG8_BAR; PG8_WAIT_L(0); PG8_MMA(0, 0, At, B0); PG8_BAR; PG8_SCHED;
            PG8_LDB(B1, 0, 1); PG8_STAGE(PG8_SB(0, 0), b2, voffB);
            PG8_BAR; PG8_WAIT_L(0); PG8_MMA(0, 1, At, B1); PG8_BAR;
            PG8_LDA(At, 0, 1); PG8_STAGE(PG8_SA(0, 0), a2, voffA);
            PG8_BAR; PG8_WAIT_L(0); PG8_MMA(1, 0, At, B0); PG8_BAR; PG8_SCHED;
            PG8_STAGE(PG8_SB(0, 1), b2 + hstep, voffB);
            PG8_WAIT_V(6); PG8_BAR; PG8_MMA(1, 1, At, B1); PG8_BAR;
            PG8_LDB(B0, 1, 0); PG8_SCHED; PG8_LDA(At, 1, 0); PG8_STAGE(PG8_SA(0, 1), a2 + hstep, voffA);
            PG8_WAIT_L(8); PG8_BAR; PG8_WAIT_L(0); PG8_MMA(0, 0, At, B0); PG8_BAR; PG8_SCHED;
            PG8_LDB(B1, 1, 1); PG8_STAGE(PG8_SB(1, 0), b3, voffB);
            PG8_BAR; PG8_WAIT_L(0); PG8_MMA(0, 1, At, B1); PG8_BAR;
            PG8_LDA(At, 1, 1); PG8_STAGE(PG8_SA(1, 0), a3, voffA);
            PG8_BAR; PG8_WAIT_L(0); PG8_MMA(1, 0, At, B0); PG8_BAR; PG8_SCHED;
            PG8_STAGE(PG8_SB(1, 1), b3 + hstep, voffB);
            PG8_WAIT_V(6); PG8_BAR; PG8_MMA(1, 1, At, B1); PG8_BAR;
        }
        E(acc, sv, cur, wr, wc, fr, fq);
        if (!has_next) break;
        E.prefetch(sv, nxt, wr, fr);
#pragma unroll
        for (int a = 0; a < 2; ++a)
#pragma unroll
            for (int b = 0; b < 2; ++b)
#pragma unroll
                for (int m = 0; m < 4; ++m)
#pragma unroll
                    for (int n = 0; n < 2; ++n) acc[a][b][m][n] = (f32x4){0.f, 0.f, 0.f, 0.f};
        cur = nxt; cA = nA; cB = nB; ++ui;
    }
    PG8_WAIT_V(0);
    if (wr == 0) PG8_BAR;
    PG8_BAR;
#undef PG8_SA
#undef PG8_SB
#undef PG8_STAGE
#undef PG8_LDA
#undef PG8_LDB
#undef PG8_MMA
#undef PG8_WAIT_V
#undef PG8_WAIT_L
#undef PG8_BAR
#undef PG8_SCHED
}
}

typedef float cf __attribute__((ext_vector_type(2)));
#define CF(a, b) ((cf){(a), (b)})
__host__ __device__ __forceinline__ cf cmul(cf a, cf b) { return CF(a.x * b.x - a.y * b.y, a.x * b.y + a.y * b.x); }
__host__ __device__ __forceinline__ cf cmulc(cf a, cf b) { return CF(a.x * b.x + a.y * b.y, a.y * b.x - a.x * b.y); }
__host__ __device__ __forceinline__ cf cadd(cf a, cf b) { return CF(a.x + b.x, a.y + b.y); }
__host__ __device__ __forceinline__ cf csub(cf a, cf b) { return CF(a.x - b.x, a.y - b.y); }
__host__ __device__ __forceinline__ int phys(int a) { return a + (a >> 4); }
__host__ __device__ __forceinline__ cf w16(int e) {
    switch (e) {
        case 0: return CF(1.0f, 0.0f);
        case 1: return CF(0.9238795325112867f, -0.3826834323650898f);
        case 2: return CF(0.7071067811865476f, -0.7071067811865476f);
        case 3: return CF(0.3826834323650898f, -0.9238795325112867f);
        case 4: return CF(0.0f, -1.0f);
        case 5: return CF(-0.3826834323650898f, -0.9238795325112867f);
        case 6: return CF(-0.7071067811865476f, -0.7071067811865476f);
        default: return CF(-0.9238795325112867f, -0.3826834323650898f);
    }
}
template <int R> __host__ __device__ __forceinline__ constexpr int bitrev_r(int k) {
    return (R == 2) ? k : (R == 4) ? (((k & 1) << 1) | (k >> 1)) : (((k & 1) << 3) | ((k & 2) << 1) | ((k & 4) >> 1) | ((k & 8) >> 3));
}
template <int R> struct LogR { static constexpr int v = (R == 16) ? 4 : (R == 4) ? 2 : 1; };
__host__ __device__ __forceinline__ cf twiddle_base(int n, int M) {
    float s, c; const float x = 2.0f * (float)n / (float)M;
#if defined(__HIP_DEVICE_COMPILE__)
    s = __builtin_amdgcn_sinf(0.5f * x); c = __builtin_amdgcn_cosf(0.5f * x);
#else
    s = (float)sin(3.14159265358979323846 * (double)x); c = (float)cos(3.14159265358979323846 * (double)x);
#endif
    return CF(c, -s);
}
__host__ __device__ __forceinline__ void mulw(float& r, float& i, int e, bool conj) {
    const float c8 = 0.7071067811865476f;
    if (e == 0) return;
    if (e == 4) { const float t = r; if (!conj) { r = i; i = -t; } else { r = -i; i = t; } return; }
    if (e == 2) { const float a = r, b = i; if (!conj) { r = (a + b) * c8; i = (b - a) * c8; } else { r = (a - b) * c8; i = (a + b) * c8; } return; }
    if (e == 6) { const float a = r, b = i; if (!conj) { r = (b - a) * c8; i = -(a + b) * c8; } else { r = -(a + b) * c8; i = (a - b) * c8; } return; }
    const cf w = w16(e); const float wr = w.x, wi = conj ? -w.y : w.y;
    const float a = r, b = i; r = a * wr - b * wi; i = a * wi + b * wr;
}
template <int R> __host__ __device__ __forceinline__ void make_tw(float (&twr)[R], float (&twi)[R], int n, int M) {
    twr[0] = 1.f; twi[0] = 0.f;
    if (R > 1) { const cf b = twiddle_base(n, M); twr[1] = b.x; twi[1] = b.y; }
#pragma unroll
    for (int k = 2; k < R; ++k) {
        const int p = (k & 1) ? k - 1 : k / 2, q = (k & 1) ? 1 : k / 2;
        twr[k] = twr[p] * twr[q] - twi[p] * twi[q]; twi[k] = twr[p] * twi[q] + twi[p] * twr[q];
    }
}

template <int R, bool TW, typename XP> __host__ __device__ __forceinline__ void fwd_pass(XP X, int N, int M, int tid) {
    const int m = M / R, ps = (m >= 16) ? m + (m >> 4) : m;
    LAUNDER(tid);
    const bool shared_n = TW && (NT % m == 0);
    float twr[R], twi[R];
    if (shared_n) make_tw<R>(twr, twi, tid % m, M);
#pragma unroll 2
    for (int g = tid; g < N / R; g += NT) {
        const int n = g % m, B = (g / m) * M, pb = phys(B + n);
        float vr[R], vi[R];
#pragma unroll
        for (int j = 0; j < R; ++j) { const cf t = X[pb + j * ps]; vr[j] = t.x; vi[j] = t.y; }
#pragma unroll
        for (int st = 0; st < LogR<R>::v; ++st) {
            const int h = (R / 2) >> st;
#pragma unroll
            for (int j = 0; j < R; ++j) {
                if ((j & h) == 0) {
                    const float ar = vr[j], ai = vi[j], br = vr[j + h], bi = vi[j + h];
                    vr[j] = ar + br; vi[j] = ai + bi;
                    float dr = ar - br, di = ai - bi;
                    mulw(dr, di, (j % h) * (16 / (2 * h)), false);
                    vr[j + h] = dr; vi[j + h] = di;
                }
            }
        }
        if (TW) {
            if (!shared_n) make_tw<R>(twr, twi, n, M);
#pragma unroll
            for (int k = 0; k < R; ++k) { const int q = bitrev_r<R>(k); X[pb + k * ps] = CF(vr[q] * twr[k] - vi[q] * twi[k], vr[q] * twi[k] + vi[q] * twr[k]); }
        } else {
#pragma unroll
            for (int k = 0; k < R; ++k) { const int q = bitrev_r<R>(k); X[pb + k * ps] = CF(vr[q], vi[q]); }
        }
    }
}
template <int R, bool TW, typename XP> __host__ __device__ __forceinline__ void inv_pass(XP X, int N, int M, int tid) {
    const int m = M / R, ps = (m >= 16) ? m + (m >> 4) : m;
    LAUNDER(tid);
    const bool shared_n = TW && (NT % m == 0);
    float twr[R], twi[R];
    if (shared_n) make_tw<R>(twr, twi, tid % m, M);
#pragma unroll 2
    for (int g = tid; g < N / R; g += NT) {
        const int n = g % m, B = (g / m) * M, pb = phys(B + n);
        float vr[R], vi[R];
        if (TW) {
            if (!shared_n) make_tw<R>(twr, twi, n, M);
#pragma unroll
            for (int k = 0; k < R; ++k) { const cf t = X[pb + k * ps]; const int q = bitrev_r<R>(k); vr[q] = t.x * twr[k] + t.y * twi[k]; vi[q] = t.y * twr[k] - t.x * twi[k]; }
        } else {
#pragma unroll
            for (int k = 0; k < R; ++k) { const cf t = X[pb + k * ps]; const int q = bitrev_r<R>(k); vr[q] = t.x; vi[q] = t.y; }
        }
#pragma unroll
        for (int st = 0; st < LogR<R>::v; ++st) {
            const int h = 1 << st;
#pragma unroll
            for (int j = 0; j < R; ++j) {
                if ((j & h) == 0) {
                    const float ar = vr[j], ai = vi[j]; float br = vr[j + h], bi = vi[j + h];
                    mulw(br, bi, (j % h) * (16 / (2 * h)), true);
                    vr[j] = ar + br; vi[j] = ai + bi; vr[j + h] = ar - br; vi[j + h] = ai - bi;
                }
            }
        }
#pragma unroll
        for (int j = 0; j < R; ++j) X[pb + j * ps] = CF(vr[j], vi[j]);
    }
}
template <int R0, typename XP> __host__ __device__ __forceinline__ void fwd_first_zp(XP X, int N, int tid) {
    const int m = N / R0, ps = m + (m >> 4);
    LAUNDER(tid);
#pragma unroll 2
    for (int n = tid; n < m; n += NT) {
        const int pb = phys(n);
        float twr[R0], twi[R0]; make_tw<R0>(twr, twi, n, N);
        const cf x0 = X[pb];
        if (R0 == 4) {
            const cf x1 = X[pb + ps];
            const float v1r = x0.x + x1.y, v1i = x0.y - x1.x, v2r = x0.x - x1.x, v2i = x0.y - x1.y, v3r = x0.x - x1.y, v3i = x0.y + x1.x;
            X[pb] = CF(x0.x + x1.x, x0.y + x1.y);
            X[pb + ps] = CF(v1r * twr[1] - v1i * twi[1], v1r * twi[1] + v1i * twr[1]);
            X[pb + 2 * ps] = CF(v2r * twr[R0 - 2] - v2i * twi[R0 - 2], v2r * twi[R0 - 2] + v2i * twr[R0 - 2]);
            X[pb + 3 * ps] = CF(v3r * twr[R0 - 1] - v3i * twi[R0 - 1], v3r * twi[R0 - 1] + v3i * twr[R0 - 1]);
        } else {
            X[pb + ps] = CF(x0.x * twr[1] - x0.y * twi[1], x0.x * twi[1] + x0.y * twr[1]);
        }
    }
}
template <int R0, typename XP> __host__ __device__ __forceinline__ void inv_last_lo(XP X, int N, int tid) {
    const int m = N / R0, ps = m + (m >> 4);
    LAUNDER(tid);
#pragma unroll 2
    for (int n = tid; n < m; n += NT) {
        const int pb = phys(n);
        float twr[R0], twi[R0]; make_tw<R0>(twr, twi, n, N);
        float ur[R0], ui[R0];
#pragma unroll
        for (int k = 0; k < R0; ++k) { const cf t = X[pb + k * ps]; ur[k] = t.x * twr[k] + t.y * twi[k]; ui[k] = t.y * twr[k] - t.x * twi[k]; }
        if (R0 == 4) {
            X[pb] = CF(ur[0] + ur[1] + ur[R0 - 2] + ur[R0 - 1], ui[0] + ui[1] + ui[R0 - 2] + ui[R0 - 1]);
            X[pb + ps] = CF((ur[0] - ur[R0 - 2]) - (ui[1] - ui[R0 - 1]), (ui[0] - ui[R0 - 2]) + (ur[1] - ur[R0 - 1]));
        } else {
            X[pb] = CF(ur[0] + ur[1], ui[0] + ui[1]);
        }
    }
}
template <typename XP, typename SP> __host__ __device__ __forceinline__ void mid_pass(XP X, SP spec, int N, int tid) {
    LAUNDER(tid);
#pragma unroll 2
    for (int g = tid; g < N / 16; g += NT) {
        const int pb = 17 * g;
        float vr[16], vi[16];
#pragma unroll
        for (int j = 0; j < 16; ++j) { const cf t = X[pb + j]; vr[j] = t.x; vi[j] = t.y; }
        cf sp[16];
#pragma unroll
        for (int k = 0; k < 16; ++k) sp[k] = spec[16 * g + k];
#pragma unroll
        for (int st = 0; st < 4; ++st) {
            const int h = 8 >> st;
#pragma unroll
            for (int j = 0; j < 16; ++j) {
                if ((j & h) == 0) {
                    const float ar = vr[j], ai = vi[j], br = vr[j + h], bi = vi[j + h];
                    vr[j] = ar + br; vi[j] = ai + bi;
                    float dr = ar - br, di = ai - bi;
                    mulw(dr, di, (j % h) * (16 / (2 * h)), false);
                    vr[j + h] = dr; vi[j + h] = di;
                }
            }
        }
#pragma unroll
        for (int k = 0; k < 16; ++k) { const int q = bitrev_r<16>(k); const float a = vr[q], b = vi[q]; vr[q] = a * sp[k].x - b * sp[k].y; vi[q] = a * sp[k].y + b * sp[k].x; }
#pragma unroll
        for (int st = 0; st < 4; ++st) {
            const int h = 1 << st;
#pragma unroll
            for (int j = 0; j < 16; ++j) {
                if ((j & h) == 0) {
                    const float ar = vr[j], ai = vi[j]; float br = vr[j + h], bi = vi[j + h];
                    mulw(br, bi, (j % h) * (16 / (2 * h)), true);
                    vr[j] = ar + br; vi[j] = ai + bi; vr[j + h] = ar - br; vi[j + h] = ai - bi;
                }
            }
        }
#pragma unroll
        for (int j = 0; j < 16; ++j) X[pb + j] = CF(vr[j], vi[j]);
    }
}
typedef unsigned short hbf16_t;
__host__ __device__ __forceinline__ float hbf2f(hbf16_t b) { return __builtin_bit_cast(float, ((unsigned)b) << 16); }
__host__ __device__ __forceinline__ hbf16_t hf2bf(float f) { unsigned u = __builtin_bit_cast(unsigned, f); u += 0x7FFFu + ((u >> 16) & 1u); return (hbf16_t)(u >> 16); }
template <int R0, typename XP> __host__ __device__ __forceinline__ void first_from_global(XP X, const hbf16_t* va, const hbf16_t* vb, int N, int tid) {
    const int m = N / R0, ps = m + (m >> 4);
    LAUNDER(tid);
#pragma unroll 2
    for (int n = tid; n < m; n += NT) {
        const int pb = phys(n);
        float twr[R0], twi[R0]; make_tw<R0>(twr, twi, n, N);
        const cf x0 = CF(hbf2f(va[n]), hbf2f(vb[n]));
        if (R0 == 4) {
            const cf x1 = CF(hbf2f(va[n + m]), hbf2f(vb[n + m]));
            const float v1r = x0.x + x1.y, v1i = x0.y - x1.x, v2r = x0.x - x1.x, v2i = x0.y - x1.y, v3r = x0.x - x1.y, v3i = x0.y + x1.x;
            X[pb] = CF(x0.x + x1.x, x0.y + x1.y);
            X[pb + ps] = CF(v1r * twr[1] - v1i * twi[1], v1r * twi[1] + v1i * twr[1]);
            X[pb + 2 * ps] = CF(v2r * twr[R0 - 2] - v2i * twi[R0 - 2], v2r * twi[R0 - 2] + v2i * twr[R0 - 2]);
            X[pb + 3 * ps] = CF(v3r * twr[R0 - 1] - v3i * twi[R0 - 1], v3r * twi[R0 - 1] + v3i * twr[R0 - 1]);
        } else {
            X[pb] = x0;
            X[pb + ps] = CF(x0.x * twr[1] - x0.y * twi[1], x0.x * twi[1] + x0.y * twr[1]);
        }
    }
}
template <int R0, int ORD, typename XP> __host__ __device__ __forceinline__ void last_fused(XP X, const hbf16_t* ga, const hbf16_t* gb, hbf16_t* va, hbf16_t* vb, cf* ZST, float sk, int N, int tid) {
    const int m = N / R0, ps = m + (m >> 4);
    LAUNDER(tid);
#pragma unroll 2
    for (int n = tid; n < m; n += NT) {
        const int pb = phys(n);
        float twr[R0], twi[R0]; make_tw<R0>(twr, twi, n, N);
        float ur[R0], ui[R0];
#pragma unroll
        for (int k = 0; k < R0; ++k) { const cf t = X[pb + k * ps]; ur[k] = t.x * twr[k] + t.y * twi[k]; ui[k] = t.y * twr[k] - t.x * twi[k]; }
        cf y[R0 / 2];
        if (R0 == 4) {
            y[0] = CF(ur[0] + ur[1] + ur[R0 - 2] + ur[R0 - 1], ui[0] + ui[1] + ui[R0 - 2] + ui[R0 - 1]);
            y[R0 / 2 - 1] = CF((ur[0] - ur[R0 - 2]) - (ui[1] - ui[R0 - 1]), (ui[0] - ui[R0 - 2]) + (ur[1] - ur[R0 - 1]));
        } else {
            y[0] = CF(ur[0] + ur[1], ui[0] + ui[1]);
        }
        cf z[R0 / 2];
#pragma unroll
        for (int e = 0; e < R0 / 2; ++e) {
            const int t = n + e * m;
            if (ORD == 0) {
                z[e] = CF(hbf2f(ga[t]) * (y[e].x + hbf2f(va[t]) * sk), hbf2f(gb[t]) * (y[e].y + hbf2f(vb[t]) * sk));
                ZST[t] = z[e];
            } else {
                const cf z1 = ZST[t];
                va[t] = hf2bf(hbf2f(ga[t]) * (y[e].x + z1.x * sk)); vb[t] = hf2bf(hbf2f(gb[t]) * (y[e].y + z1.y * sk));
            }
        }
        if (ORD == 0) {
            const cf x0 = z[0];
            if (R0 == 4) {
                const cf x1 = z[R0 / 2 - 1];
                const float v1r = x0.x + x1.y, v1i = x0.y - x1.x, v2r = x0.x - x1.x, v2i = x0.y - x1.y, v3r = x0.x - x1.y, v3i = x0.y + x1.x;
                X[pb] = CF(x0.x + x1.x, x0.y + x1.y);
                X[pb + ps] = CF(v1r * twr[1] - v1i * twi[1], v1r * twi[1] + v1i * twr[1]);
                X[pb + 2 * ps] = CF(v2r * twr[R0 - 2] - v2i * twi[R0 - 2], v2r * twi[R0 - 2] + v2i * twr[R0 - 2]);
                X[pb + 3 * ps] = CF(v3r * twr[R0 - 1] - v3i * twi[R0 - 1], v3r * twi[R0 - 1] + v3i * twr[R0 - 1]);
            } else {
                X[pb] = x0;
                X[pb + ps] = CF(x0.x * twr[1] - x0.y * twi[1], x0.x * twi[1] + x0.y * twr[1]);
            }
        }
    }
}
#if !defined(FFT_HOST_TEST)
#define FFT_SYNC() __syncthreads()
template <int N, bool ZP> __device__ __forceinline__ void fft_fwd(LAS cf* X, int tid) {
    if (ZP) fwd_first_zp<N / 4096>(X, N, tid); else fwd_pass<N / 4096, true>(X, N, N, tid);
    FFT_SYNC();
    fwd_pass<16, true>(X, N, 4096, tid); FFT_SYNC();
    fwd_pass<16, true>(X, N, 256, tid); FFT_SYNC();
    fwd_pass<16, false>(X, N, 16, tid); FFT_SYNC();
}
template <int N> __device__ __forceinline__ void fft_conv(LAS cf* X, const cf* spec, int tid) {
    fwd_first_zp<N / 4096>(X, N, tid); FFT_SYNC();
    fwd_pass<16, true>(X, N, 4096, tid); FFT_SYNC();
    fwd_pass<16, true>(X, N, 256, tid); FFT_SYNC();
    mid_pass(X, spec, N, tid); FFT_SYNC();
    inv_pass<16, true>(X, N, 256, tid); FFT_SYNC();
    inv_pass<16, true>(X, N, 4096, tid); FFT_SYNC();
    inv_last_lo<N / 4096>(X, N, tid); FFT_SYNC();
}
template <int N> __device__ __forceinline__ void conv_core(LAS cf* X, const cf* spec, int tid) {
    fwd_pass<16, true>(X, N, 4096, tid); FFT_SYNC();
    fwd_pass<16, true>(X, N, 256, tid); FFT_SYNC();
    mid_pass(X, spec, N, tid); FFT_SYNC();
    inv_pass<16, true>(X, N, 256, tid); FFT_SYNC();
    inv_pass<16, true>(X, N, 4096, tid); FFT_SYNC();
}
template <int N> __device__ __forceinline__ void fft_inv(LAS cf* X, int tid) {
    inv_pass<16, false>(X, N, 16, tid); FFT_SYNC();
    inv_pass<16, true>(X, N, 256, tid); FFT_SYNC();
    inv_pass<16, true>(X, N, 4096, tid); FFT_SYNC();
    inv_last_lo<N / 4096>(X, N, tid); FFT_SYNC();
}
#endif

#if !defined(FFT_HOST_TEST)
__device__ __forceinline__ void phase_rmsnorm(const float* src0, const float* src1, const float* g, bf16_t* dst_bf, float* dst_f) {
    int tid = threadIdx.x; LAUNDER(tid);
    const int lane = tid & 63, wv = tid >> 6;
    const int gw = blockIdx.x * 8 + wv, nw = gridDim.x * 8;
    f32x4 gv[4];
#pragma unroll
    for (int i = 0; i < 4; ++i) gv[i] = *(const f32x4*)(g + 4 * (lane + 64 * i));
    for (int row = gw; row < NTOK; row += nw) {
        const float* src = (row < 32768) ? src0 + (size_t)row * 1024 : src1 + (size_t)(row - 32768) * 1024;
        f32x4 v[4]; float ss = 0.f;
#pragma unroll
        for (int i = 0; i < 4; ++i) { v[i] = *(const f32x4*)(src + 4 * (lane + 64 * i)); ss += v[i][0] * v[i][0] + v[i][1] * v[i][1] + v[i][2] * v[i][2] + v[i][3] * v[i][3]; }
        ss = wave_sum(ss);
        const float rstd = rsqrtf(ss * (1.0f / 1024.0f) + 1e-5f);
#pragma unroll
        for (int i = 0; i < 4; ++i) {
            f32x4 o = v[i] * rstd * gv[i];
            if (dst_bf) { u32x2 p; p.x = pk2(o[0], o[1]); p.y = pk2(o[2], o[3]); *(u32x2*)(dst_bf + (size_t)row * 1024 + 4 * (lane + 64 * i)) = p; }
            else *(f32x4*)(dst_f + (size_t)row * 1024 + 4 * (lane + 64 * i)) = o;
        }
    }
}

__device__ __forceinline__ void phase_prep_x(const Params& p) {
    int tid = threadIdx.x; LAUNDER(tid);
    const int lane = tid & 63, wv = tid >> 6;
    const int gw = blockIdx.x * 8 + wv, nw = gridDim.x * 8;
    bf16_t* XB = (bf16_t*)(p.ws + OFF_HN); float* SS = (float*)(p.ws + OFF_SS);
    for (int i = blockIdx.x * NT + tid; i < 4 * 65536; i += gridDim.x * NT) SS[65536 + i] = 0.f;
    for (int row = gw; row < NTOK; row += nw) {
        const float* src = (row < 32768) ? p.in[0] + (size_t)row * 1024 : p.in[1] + (size_t)(row - 32768) * 1024;
        float ss = 0.f;
#pragma unroll
        for (int i = 0; i < 4; ++i) {
            const f32x4 v = *(const f32x4*)(src + 4 * (lane + 64 * i)); ss += v[0] * v[0] + v[1] * v[1] + v[2] * v[2] + v[3] * v[3];
            u32x2 o; o.x = pk2(v[0], v[1]); o.y = pk2(v[2], v[3]); *(u32x2*)(XB + (size_t)row * 1024 + 4 * (lane + 64 * i)) = o;
        }
        ss = wave_sum(ss);
        if (lane == 0) SS[row] = ss;
    }
}
__device__ __forceinline__ void phase_final_norm(const Params& p) {
    int tid = threadIdx.x; LAUNDER(tid);
    const float* SS4 = (const float*)(p.ws + OFF_SS) + 4 * 65536; const float* g = p.in[4];
    const u32x4* XB = (const u32x4*)(p.ws + OFF_BIG);
    const size_t stride = (size_t)gridDim.x * NT, total = (size_t)NTOK * 128;
    for (size_t i = (size_t)blockIdx.x * NT + tid; i < total; i += 2 * stride) {
        const size_t j = i + stride; const bool hasB = j < total;
        const u32x4 ta = XB[i], tb = XB[hasB ? j : i];
        const int rowA = (int)(i >> 7), cA = (int)(i & 127), rowB = (int)((hasB ? j : i) >> 7), cB = (int)((hasB ? j : i) & 127);
        const float sa = SS4[rowA], sb = SS4[rowB];
        const f32x4 ga0 = *(const f32x4*)(g + 8 * cA), ga1 = *(const f32x4*)(g + 8 * cA + 4), gb0 = *(const f32x4*)(g + 8 * cB), gb1 = *(const f32x4*)(g + 8 * cB + 4);
        const float ra = rsqrtf(sa * (1.0f / 1024.0f) + 1e-5f), rb = rsqrtf(sb * (1.0f / 1024.0f) + 1e-5f);
        f32x4 a0, a1, b0, b1;
        a0[0] = __uint_as_float(ta.x << 16); a0[1] = __uint_as_float(ta.x & 0xffff0000u); a0[2] = __uint_as_float(ta.y << 16); a0[3] = __uint_as_float(ta.y & 0xffff0000u);
        a1[0] = __uint_as_float(ta.z << 16); a1[1] = __uint_as_float(ta.z & 0xffff0000u); a1[2] = __uint_as_float(ta.w << 16); a1[3] = __uint_as_float(ta.w & 0xffff0000u);
        b0[0] = __uint_as_float(tb.x << 16); b0[1] = __uint_as_float(tb.x & 0xffff0000u); b0[2] = __uint_as_float(tb.y << 16); b0[3] = __uint_as_float(tb.y & 0xffff0000u);
        b1[0] = __uint_as_float(tb.z << 16); b1[1] = __uint_as_float(tb.z & 0xffff0000u); b1[2] = __uint_as_float(tb.w << 16); b1[3] = __uint_as_float(tb.w & 0xffff0000u);
        float* opa = p.out + (size_t)rowA * 1024 + 8 * cA;
        *(f32x4*)opa = a0 * ra * ga0; *(f32x4*)(opa + 4) = a1 * ra * ga1;
        if (hasB) { float* opb = p.out + (size_t)rowB * 1024 + 8 * cB; *(f32x4*)opb = b0 * rb * gb0; *(f32x4*)(opb + 4) = b1 * rb * gb1; }
    }
}

__device__ __forceinline__ void phase_weights(const Params& p, LAS float* T) {
    int tid = threadIdx.x; LAUNDER(tid);
    for (int mi = 0; mi < 8; ++mi) {
        const float* src; bf16_t* dst; int K, N; bool perm = false; const float* gain = nullptr;
        switch (mi) {
            case 0: src = p.in[5]; dst = (bf16_t*)(p.ws + OFF_WIN); K = 1024; N = 2560; perm = true; gain = p.in[2]; break;
            case 1: src = p.in[6]; dst = (bf16_t*)(p.ws + OFF_WOUT); K = 1024; N = 1024; break;
            case 2: src = p.in[23]; dst = (bf16_t*)(p.ws + OFF_WQKV); K = 1024; N = 1536; gain = p.in[2] + 1024; break;
            case 3: src = p.in[25]; dst = (bf16_t*)(p.ws + OFF_WO); K = 1024; N = 1024; break;
            case 4: src = p.in[26]; dst = (bf16_t*)(p.ws + OFF_WUP); K = 1024; N = 4096; gain = p.in[3]; break;
            case 5: src = p.in[26] + N_WFF; dst = (bf16_t*)(p.ws + OFF_WUP) + N_WFF; K = 1024; N = 4096; gain = p.in[3] + 1024; break;
            case 6: src = p.in[27]; dst = (bf16_t*)(p.ws + OFF_WDN); K = 4096; N = 1024; break;
            default: src = p.in[27] + N_WFF; dst = (bf16_t*)(p.ws + OFF_WDN) + N_WFF; K = 4096; N = 1024; break;
        }
        const int tk = K / 64, tn = N / 64;
        float rv[8];
        int it = blockIdx.x;
        if (it < tk * tn) {
            const int k0 = (it / tn) * 64, n0 = (it % tn) * 64;
#pragma unroll
            for (int i = 0; i < 8; ++i) { const int idx = tid + NT * i, r = idx >> 6, c = idx & 63; rv[i] = src[(size_t)(k0 + r) * N + n0 + c] * (gain ? gain[k0 + r] : 1.0f); }
        }
        for (; it < tk * tn; it += gridDim.x) {
            const int k0 = (it / tn) * 64, n0 = (it % tn) * 64;
#pragma unroll
            for (int i = 0; i < 8; ++i) { const int idx = tid + NT * i, r = idx >> 6, c = idx & 63; T[r * 65 + c] = rv[i]; }
            __syncthreads();
            const int nit = it + gridDim.x;
            if (nit < tk * tn) {
                const int k1 = (nit / tn) * 64, n1 = (nit % tn) * 64;
#pragma unroll
                for (int i = 0; i < 8; ++i) { const int idx = tid + NT * i, r = idx >> 6, c = idx & 63; rv[i] = src[(size_t)(k1 + r) * N + n1 + c] * (gain ? gain[k1 + r] : 1.0f); }
            }
#pragma unroll
            for (int i = 0; i < 8; ++i) {
                const int idx = tid + NT * i, nl = idx >> 6, kl = idx & 63; int n = n0 + nl;
                if (perm && n < 1024) { const int nn = n & 511, q = nn >> 2, e = nn & 3; n = 8 * q + e + ((n >= 512) ? 4 : 0); }
                dst[(size_t)n * K + k0 + kl] = f2bf(T[kl * 65 + nl]);
            }
            __syncthreads();
        }
    }
}

__device__ __forceinline__ void phase_filter_hidden(const Params& p, LAS float* WL) {
    int tid = threadIdx.x; LAUNDER(tid);
    const int lane = tid & 63, wv = tid >> 6;
    const int gw = blockIdx.x * 8 + wv, nw = gridDim.x * 8;
    const float* w1 = p.in[13]; const float* b1 = p.in[14]; const float* w2 = p.in[15]; const float* b2 = p.in[16];
    const float* w3 = p.in[17]; const float* b3 = p.in[18]; const float* fr = p.in[20];
    float* H3 = (float*)(p.ws + OFF_H3);
    LAS float* w1r = WL; LAS float* w2r = WL + 33 * 64; LAS float* w3r = w2r + 64 * 64;
    __syncthreads();
    for (int i = tid; i < 33 * 64; i += NT) w1r[i] = w1[i];
    for (int i = tid; i < 64 * 64; i += NT) { w2r[i] = w2[i]; w3r[i] = w3[i]; }
    __syncthreads();
    const float bb1 = b1[lane], bb2 = b2[lane], bb3 = b3[lane], f1 = fr[lane], f2 = fr[64 + lane], f3 = fr[128 + lane];
    for (int pg = gw; pg < 12288; pg += nw) {
        const int L = (pg < 8192) ? 8192 : 4096, pos = (pg < 8192) ? pg : pg - 8192;
        const float t = (float)pos / (float)(L - 1);
        const float w = 6.283185307179586f * (float)pos / (float)L;
        float z = 0.f;
        if (lane == 0) z = t;
        else if (lane <= 32) {
            const int bi = (lane - 1) & 15;
            const float f = 1e-4f + (float)bi * ((15.0f - 1e-4f) / 15.0f);
            const float a = w * f;
            z = (lane <= 16) ? cosf(a) : -sinf(a);
        }
        float a1 = bb1;
#pragma unroll 3
        for (int i = 0; i < 33; ++i) a1 += __shfl(z, i, 64) * w1r[i * 64 + lane];
        const float h1 = sinf(f1 * a1);
        float a2 = bb2;
#pragma unroll 8
        for (int i = 0; i < 64; ++i) a2 += __shfl(h1, i, 64) * w2r[i * 64 + lane];
        const float h2 = sinf(f2 * a2);
        float a3 = bb3;
#pragma unroll 8
        for (int i = 0; i < 64; ++i) a3 += __shfl(h2, i, 64) * w3r[i * 64 + lane];
        const float h3 = sinf(f3 * a3);
        H3[(size_t)pg * 64 + lane] = h3;
    }
}

__device__ __forceinline__ void phase_conformer(const Params& p, LAS unsigned char* lds) {
    int tid = threadIdx.x; LAUNDER(tid);
    const int lane = tid & 63, wv = tid >> 6;
    const bf16_t* HCV = (const bf16_t*)p.out;
    bf16_t* YCAT = (bf16_t*)(p.ws + OFF_HN);
    LAS bf16_t* hb = (LAS bf16_t*)lds;
    LAS float* ob = (LAS float*)(lds + 62 * 512 * 2);
    const float* dw = p.in[7]; const float* db = p.in[8]; const float* lg = p.in[9]; const float* lb = p.in[10];
    float w[31];
#pragma unroll
    for (int k = 0; k < 31; ++k) w[k] = dw[k * 512 + tid];
    const float bias = db[tid];
    float gg[8], bb[8];
#pragma unroll
    for (int i = 0; i < 8; ++i) { gg[i] = lg[lane * 8 + i]; bb[i] = lb[lane * 8 + i]; }
    u32x4 pre[8];
    auto cf_load = [&](int item) {
        const int rowbase = item * 32; int L, row0; seq_of_row(rowbase, L, row0);
        const int t0 = rowbase - row0;
#pragma unroll
        for (int k = 0; k < 8; ++k) {
            const int idx = tid + NT * k, r = idx >> 6, c8 = idx & 63, t = t0 - 15 + r;
            pre[k] = (u32x4){0u, 0u, 0u, 0u};
            if (idx < 62 * 64 && t >= 0 && t < L) pre[k] = *(const u32x4*)(HCV + (size_t)(row0 + t) * 512 + c8 * 8);
        }
    };
    if ((int)blockIdx.x < NTOK / 32) cf_load(blockIdx.x);
    for (int it = blockIdx.x; it < NTOK / 32; it += gridDim.x) {
        const int rowbase = it * 32;
#pragma unroll
        for (int k = 0; k < 8; ++k) { const int idx = tid + NT * k, r = idx >> 6, c8 = idx & 63; if (idx < 62 * 64) *(LAS u32x4*)(hb + r * 512 + c8 * 8) = pre[k]; }
        __syncthreads();
        if (it + (int)gridDim.x < NTOK / 32) cf_load(it + gridDim.x);
        float acc[32];
#pragma unroll
        for (int i = 0; i < 32; ++i) acc[i] = bias;
#pragma unroll
        for (int r = 0; r < 62; ++r) {
            const float val = bf2f(hb[r * 512 + tid]);
#pragma unroll
            for (int tt = 0; tt < 32; ++tt) { if (r - tt >= 0 && r - tt < 31) acc[tt] += w[r - tt] * val; }
        }
#pragma unroll
        for (int tt = 0; tt < 32; ++tt) ob[tt * 512 + tid] = acc[tt];
        __syncthreads();
#pragma unroll
        for (int i = 0; i < 4; ++i) {
            const int tt = wv + 8 * i;
            f32x4 v0 = *(const LAS f32x4*)(ob + tt * 512 + lane * 8), v1 = *(const LAS f32x4*)(ob + tt * 512 + lane * 8 + 4);
            float s = v0[0] + v0[1] + v0[2] + v0[3] + v1[0] + v1[1] + v1[2] + v1[3];
            s = wave_sum(s); const float mu = s * (1.0f / 512.0f);
            float x[8]; float q = 0.f;
#pragma unroll
            for (int j = 0; j < 4; ++j) { x[j] = v0[j] - mu; x[4 + j] = v1[j] - mu; }
#pragma unroll
            for (int j = 0; j < 8; ++j) q += x[j] * x[j];
            q = wave_sum(q); const float rstd = rsqrtf(q * (1.0f / 512.0f) + 1e-5f);
            float y[8];
#pragma unroll
            for (int j = 0; j < 8; ++j) { const float a = x[j] * rstd * gg[j] + bb[j]; y[j] = a * __builtin_amdgcn_rcpf(1.0f + __expf(-a)); }
            u32x4 o; o.x = pk2(y[0], y[1]); o.y = pk2(y[2], y[3]); o.z = pk2(y[4], y[5]); o.w = pk2(y[6], y[7]);
            *(u32x4*)(YCAT + (size_t)(rowbase + tt) * 1024 + lane * 8) = o;
        }
        __syncthreads();
    }
}

__device__ __forceinline__ void phase_shortconv_T(const Params& p, LAS float* U) {
    int tid = threadIdx.x; LAUNDER(tid);
    const bf16_t* UHY = (const bf16_t*)p.out + (size_t)NTOK * 512;
    bf16_t* XT = (bf16_t*)(p.ws + OFF_BIG);
    const float* sw = p.in[11]; const float* sb = p.in[12];
    const int lane = tid & 63, wv = __builtin_amdgcn_readfirstlane(tid >> 6);
    u32x4 pre[5];
    constexpr int NIT = (NTOK / 128) * 12;
    auto sc_load = [&](int item) {
        const int tile = item / 12, cht = item % 12, rowbase = tile * 128; int L, row0; seq_of_row(rowbase, L, row0);
        const int t0 = rowbase - row0;
#pragma unroll
        for (int k = 0; k < 5; ++k) {
            const int idx = tid + NT * k, r = idx >> 4, c8 = idx & 15, t = t0 - 1 + r;
            pre[k] = (u32x4){0u, 0u, 0u, 0u};
            if (idx < 130 * 16 && t >= 0 && t < L) pre[k] = *(const u32x4*)(UHY + (size_t)(row0 + t) * 1536 + cht * 128 + c8 * 8);
        }
    };
    if ((int)blockIdx.x < NIT) sc_load(blockIdx.x);
    for (int it = blockIdx.x; it < NIT; it += gridDim.x) {
        const int tile = it / 12, cht = it % 12, rowbase = tile * 128; int L, row0; seq_of_row(rowbase, L, row0);
        const int t0 = rowbase - row0;
#pragma unroll
        for (int k = 0; k < 5; ++k) {
            const int idx = tid + NT * k, r = idx >> 4, c8 = idx & 15;
            if (idx < 130 * 16) {
                const u32x4 v = pre[k];
                LAS float* d = U + r * 129 + c8 * 8;
                d[0] = __uint_as_float(v.x << 16); d[1] = __uint_as_float(v.x & 0xffff0000u);
                d[2] = __uint_as_float(v.y << 16); d[3] = __uint_as_float(v.y & 0xffff0000u);
                d[4] = __uint_as_float(v.z << 16); d[5] = __uint_as_float(v.z & 0xffff0000u);
                d[6] = __uint_as_float(v.w << 16); d[7] = __uint_as_float(v.w & 0xffff0000u);
            }
        }
        __syncthreads();
        if (it + (int)gridDim.x < NIT) sc_load(it + gridDim.x);
#pragma unroll 4
        for (int i = 0; i < 16; ++i) {
            const int chl = wv + 8 * i, ch = cht * 128 + chl;
            const float w0 = sw[ch], w1 = sw[1536 + ch], w2 = sw[3072 + ch], bs = sb[ch];
            const float u0 = U[(2 * lane) * 129 + chl], u1 = U[(2 * lane + 1) * 129 + chl], u2 = U[(2 * lane + 2) * 129 + chl], u3 = U[(2 * lane + 3) * 129 + chl];
            *(unsigned*)(XT + (size_t)row0 * 1536 + (size_t)ch * L + t0 + 2 * lane) = pk2(bs + w0 * u0 + w1 * u1 + w2 * u2, bs + w0 * u1 + w1 * u2 + w2 * u3);
        }
        __syncthreads();
    }
}

__device__ __forceinline__ void phase_zT(const Params& p, LAS float* U) {
    int tid = threadIdx.x; LAUNDER(tid);
    const bf16_t* XT = (const bf16_t*)(p.ws + OFF_BIG);
    bf16_t* YCAT = (bf16_t*)(p.ws + OFF_HN);
    unsigned pre[8];
    constexpr int NIT = (NTOK / 128) * 8;
    auto zt_load = [&](int item) {
        const int tile = item / 8, cht = item % 8, rowbase = tile * 128; int L, row0; seq_of_row(rowbase, L, row0);
        const int t0 = rowbase - row0;
#pragma unroll
        for (int i = 0; i < 8; ++i) { const int idx = tid + NT * i, chl = idx >> 6, tp = idx & 63; pre[i] = *(const unsigned*)(XT + (size_t)row0 * 1536 + (size_t)(1024 + cht * 64 + chl) * L + t0 + 2 * tp); }
    };
    if ((int)blockIdx.x < NIT) zt_load(blockIdx.x);
    for (int it = blockIdx.x; it < NIT; it += gridDim.x) {
        const int tile = it / 8, cht = it % 8, rowbase = tile * 128;
#pragma unroll
        for (int i = 0; i < 8; ++i) { const int idx = tid + NT * i, chl = idx >> 6, tp = idx & 63; U[chl * 129 + 2 * tp] = __uint_as_float(pre[i] << 16); U[chl * 129 + 2 * tp + 1] = __uint_as_float(pre[i] & 0xffff0000u); }
        __syncthreads();
        if (it + (int)gridDim.x < NIT) zt_load(it + gridDim.x);
#pragma unroll
        for (int i = 0; i < 8; ++i) {
            const int idx = tid + NT * i, tl = idx >> 5, cp = idx & 31;
            *(unsigned*)(YCAT + (size_t)(rowbase + tl) * 1024 + 512 + cht * 64 + 2 * cp) = pk2(U[(2 * cp) * 129 + tl], U[(2 * cp + 1) * 129 + tl]);
        }
        __syncthreads();
    }
}

__device__ __forceinline__ float block_sum(float v, LAS float* red, int tid) {
    v = wave_sum(v);
    __syncthreads();
    if ((tid & 63) == 0) red[tid >> 6] = v;
    __syncthreads();
    float s = 0.f;
#pragma unroll
    for (int i = 0; i < 8; ++i) s += red[i];
    return s;
}
template <int L> __device__ __forceinline__ void hyena_item(const Params& p, LAS unsigned char* lds, int c) {
    constexpr int N = 2 * L, PT = L / NT;
    constexpr int NSEQ = (L == 8192) ? 4 : 8, SEQ0ROW = (L == 8192) ? 0 : 32768;
    int tid = threadIdx.x; LAUNDER(tid);
    LAS cf* X = (LAS cf*)lds;
    LAS float* red = (LAS float*)(lds + LDS_X_BYTES);
    const float* KT = p.out + ((L == 8192) ? 0 : (size_t)2048 * 8192);
    const float* skip = p.in[22];
    cf* SPEC = (cf*)(p.ws + OFF_SPEC) + (size_t)blockIdx.x * 2 * 16384;
    bf16_t* XT = (bf16_t*)(p.ws + OFF_BIG);
    cf* ZST = (cf*)(p.ws + OFF_ZST) + (size_t)blockIdx.x * 8192;
    __syncthreads();
#pragma unroll 1
    for (int ord = 0; ord < 2; ++ord) {
        const float* kf = KT + (size_t)((2 * ord) * 512 + c) * L; const float* kb = KT + (size_t)((2 * ord + 1) * 512 + c) * L;
        float ss = 0.f;
#pragma unroll 4
        for (int i = 0; i < PT; ++i) {
            const int t = tid + NT * i;
            const float a0 = kf[t], a1 = kb[t];
            ss += a0 * a0 + ((t > 0) ? a1 * a1 : 0.f);
            X[phys(t)] = CF(a0, 0.f);
            if (t > 0) X[phys(N - t)] = CF(a1, 0.f); else X[phys(L)] = CF(0.f, 0.f);
        }
        ss = block_sum(ss, red, tid);
        const float sc = rsqrtf(ss + 1e-6f) * (1.0f / (float)N);
        __syncthreads();
        fft_fwd<N, false>(X, tid);
#pragma unroll 4
        for (int a = tid; a < N; a += NT) { const cf v = X[phys(a)]; SPEC[ord * 16384 + a] = CF(v.x * sc, v.y * sc); }
        __syncthreads();
    }
    const float sk0 = skip[c], sk1 = skip[512 + c];
    for (int pr = 0; pr < NSEQ / 2; ++pr) {
        const size_t base0 = (size_t)(SEQ0ROW + (2 * pr) * L) * 1536, base1 = (size_t)(SEQ0ROW + (2 * pr + 1) * L) * 1536;
        const bf16_t* x1a = XT + base0 + (size_t)c * L;            const bf16_t* x1b = XT + base1 + (size_t)c * L;
        const bf16_t* x2a = XT + base0 + (size_t)(512 + c) * L;    const bf16_t* x2b = XT + base1 + (size_t)(512 + c) * L;
        bf16_t* va = XT + base0 + (size_t)(1024 + c) * L;          bf16_t* vb = XT + base1 + (size_t)(1024 + c) * L;
        first_from_global<N / 4096>(X, va, vb, N, tid); __syncthreads();
        conv_core<N>(X, SPEC, tid);
        last_fused<N / 4096, 0>(X, x1a, x1b, va, vb, ZST, sk0, N, tid); __syncthreads();
        conv_core<N>(X, SPEC + 16384, tid);
        last_fused<N / 4096, 1>(X, x2a, x2b, va, vb, ZST, sk1, N, tid); __syncthreads();
    }
}
__device__ __forceinline__ void phase_filters(const Params& p, LAS unsigned char* lds) {
    int tid = threadIdx.x; LAUNDER(tid);
    LAS float* Hs = (LAS float*)lds;
    LAS float* Ws = Hs + 256 * 65;
    const float* w4 = p.in[19]; const float* decay = p.in[21];
    const int tl = tid & 255, cg = __builtin_amdgcn_readfirstlane(tid >> 8);
    f32x4 ph[8], pw[2];
    auto fl_load = [&](int item) {
        int tt, ct; const float* H3;
        if (item < 1024) { tt = item >> 5; ct = item & 31; H3 = (const float*)(p.ws + OFF_H3); }
        else { const int j = item - 1024; tt = j >> 5; ct = j & 31; H3 = (const float*)(p.ws + OFF_H3) + 8192 * 64; }
#pragma unroll
        for (int k = 0; k < 8; ++k) { const int idx = tid + NT * k, r = idx >> 4, c4 = idx & 15; ph[k] = *(const f32x4*)(H3 + (size_t)(tt * 256 + r) * 64 + c4 * 4); }
#pragma unroll
        for (int k = 0; k < 2; ++k) { const int idx = tid + NT * k, j = idx >> 4, c4 = idx & 15; pw[k] = *(const f32x4*)(w4 + (size_t)j * 2048 + ct * 64 + c4 * 4); }
    };
    if ((int)blockIdx.x < 1536) fl_load(blockIdx.x);
    for (int it = blockIdx.x; it < 1536; it += gridDim.x) {
        int L, tt, ct; float* KT;
        if (it < 1024) { L = 8192; tt = it >> 5; ct = it & 31; KT = p.out; }
        else { const int j = it - 1024; L = 4096; tt = j >> 5; ct = j & 31; KT = p.out + (size_t)2048 * 8192; }
        const int t0 = tt * 256, col0 = ct * 64;
        __syncthreads();
#pragma unroll
        for (int k = 0; k < 8; ++k) {
            const int idx = tid + NT * k, r = idx >> 4, c4 = idx & 15;
            LAS float* d = Hs + r * 65 + c4 * 4; d[0] = ph[k][0]; d[1] = ph[k][1]; d[2] = ph[k][2]; d[3] = ph[k][3];
        }
#pragma unroll
        for (int k = 0; k < 2; ++k) { const int idx = tid + NT * k, j = idx >> 4, c4 = idx & 15; *(LAS f32x4*)(Ws + j * 64 + c4 * 4) = pw[k]; }
        __syncthreads();
        if (it + (int)gridDim.x < 1536) fl_load(it + gridDim.x);
        float acc[32];
#pragma unroll
        for (int i = 0; i < 32; ++i) acc[i] = 0.f;
#pragma unroll 2
        for (int j = 0; j < 64; ++j) {
            const float h = Hs[tl * 65 + j];
#pragma unroll
            for (int c8 = 0; c8 < 8; ++c8) {
                const f32x4 w = *(const LAS f32x4*)(Ws + j * 64 + cg * 32 + c8 * 4);
                acc[c8 * 4 + 0] += h * w[0]; acc[c8 * 4 + 1] += h * w[1]; acc[c8 * 4 + 2] += h * w[2]; acc[c8 * 4 + 3] += h * w[3];
            }
        }
        const float tn = (float)(t0 + tl) / (float)(L - 1);
#pragma unroll
        for (int i = 0; i < 32; ++i) {
            const int col = col0 + cg * 32 + i;
            KT[(size_t)col * L + t0 + tl] = acc[i] * __expf(-tn * fabsf(decay[col]));
        }
    }
}
__device__ __forceinline__ void phase_hyena(const Params& p, LAS unsigned char* lds) {
    for (int it = blockIdx.x; it < 1024; it += gridDim.x) {
        if (it < 512) hyena_item<8192>(p, lds, it); else hyena_item<4096>(p, lds, it - 512);
    }
}

__device__ const double ROPE_INV_REV[8] = {0.15915494309189535, 0.03086376340470123, 0.005985185712713705, 0.001160663641240061,
                                             0.00022507907903927653, 4.364795279280289e-05, 8.464330808241401e-06, 1.6414262627950345e-06};
__device__ __forceinline__ void rope_angle(int pos, int i, float& cs, float& sn) {
    double r = (double)pos * ROPE_INV_REV[i]; r -= floor(r);
    const float x = 2.0f * (float)r;
    cs = cospif(x); sn = sinpif(x);
}
__device__ __forceinline__ void phase_rope_table(const Params& p) {
    int tid = threadIdx.x; LAUNDER(tid);
    float* RT = (float*)(p.ws + OFF_ROPE);
    for (int e = blockIdx.x * NT + tid; e < 8192 * 8; e += gridDim.x * NT) {
        const int pos = e >> 3, i = e & 7; float cs, sn; rope_angle(pos, i, cs, sn);
        RT[pos * 16 + i] = cs; RT[pos * 16 + 8 + i] = sn;
    }
}
__device__ __forceinline__ void phase_attn(const Params& p, LAS unsigned char* lds) {
    int tid = threadIdx.x; LAUNDER(tid);
    const int lane = tid & 63, wv = tid >> 6, col = lane & 15, quad = lane >> 4;
    const bf16_t* QKV = (const bf16_t*)(p.ws + OFF_BIG);
    bf16_t* ATT = (bf16_t*)p.out;
    LAS bf16_t* Ks = (LAS bf16_t*)lds;
    LAS bf16_t* Vt = (LAS bf16_t*)(lds + 528 * 72 * 2);
    const float* sink = p.in[24]; const float* RT = (const float*)(p.ws + OFF_ROPE);
    constexpr float LOG2E = 1.4426950408889634f;
    for (int it = blockIdx.x; it < 1024; it += gridDim.x) {
        const int tileIdx = it >> 2, kvh = it & 3;
        int L, row0, q0;
        if (tileIdx < 128) { L = 8192; row0 = (tileIdx >> 5) * 8192; q0 = (tileIdx & 31) * 256; }
        else { const int ti = tileIdx - 128; L = 4096; row0 = 32768 + (ti >> 4) * 4096; q0 = (ti & 15) * 256; }
        const int kstart = q0 - 128;
        const bool edge = (kstart < 0) || (q0 + 256 + 144 > L);
        __syncthreads();
        {
            u32x4 k0r[5], k1r[5], vr[9]; f32x4 rc0, rc1, rs0, rs1;
            rc0 = rc1 = rs0 = rs1 = (f32x4){0.f, 0.f, 0.f, 0.f};
#pragma unroll
            for (int k = 0; k < 5; ++k) {
                const int idx = tid + NT * k; int key, ch;
                if (idx < 528) { key = idx; ch = 0; } else { const int j = idx - 528; key = j / 3; ch = 1 + (j - key * 3); }
                const int pos = kstart + key;
                k0r[k] = (u32x4){0u, 0u, 0u, 0u}; k1r[k] = k0r[k];
                if (idx < 528 * 4 && pos >= 0 && pos < L) {
                    const bf16_t* src = QKV + (size_t)(row0 + pos) * 1536 + 1024 + kvh * 64 + ch * 16;
                    k0r[k] = *(const u32x4*)src; k1r[k] = *(const u32x4*)(src + 8);
                    if (k == 0) { const float* rt = RT + pos * 16; rc0 = *(const f32x4*)rt; rc1 = *(const f32x4*)(rt + 4); rs0 = *(const f32x4*)(rt + 8); rs1 = *(const f32x4*)(rt + 12); }
                }
            }
#pragma unroll
            for (int k = 0; k < 9; ++k) {
                const int idx = tid + NT * k, c8 = idx / 528, key = idx - c8 * 528, pos = kstart + key;
                vr[k] = (u32x4){0u, 0u, 0u, 0u};
                if (idx < 528 * 8 && pos >= 0 && pos < L) vr[k] = *(const u32x4*)(QKV + (size_t)(row0 + pos) * 1536 + 1280 + kvh * 64 + c8 * 8);
            }
#pragma unroll
            for (int k = 0; k < 5; ++k) {
                const int idx = tid + NT * k;
                u32x4 v0 = k0r[k], v1 = k1r[k];
                if (k == 0 || (k == 1 && idx < 528)) {
                    if (k == 1) { const int pc = min(max(kstart + idx, 0), 8191); const float* rt = RT + pc * 16; rc0 = *(const f32x4*)rt; rc1 = *(const f32x4*)(rt + 4); rs0 = *(const f32x4*)(rt + 8); rs1 = *(const f32x4*)(rt + 12); }
                    float a[8], b[8];
#pragma unroll
                    for (int i = 0; i < 4; ++i) { a[2 * i] = __uint_as_float(v0[i] << 16); a[2 * i + 1] = __uint_as_float(v0[i] & 0xffff0000u); b[2 * i] = __uint_as_float(v1[i] << 16); b[2 * i + 1] = __uint_as_float(v1[i] & 0xffff0000u); }
#pragma unroll
                    for (int i = 0; i < 8; ++i) { const float cs = (i < 4) ? rc0[i & 3] : rc1[i & 3], sn = (i < 4) ? rs0[i & 3] : rs1[i & 3]; const float na = a[i] * cs - b[i] * sn, nb = b[i] * cs + a[i] * sn; a[i] = na; b[i] = nb; }
#pragma unroll
                    for (int i = 0; i < 4; ++i) { v0[i] = pk2(a[2 * i], a[2 * i + 1]); v1[i] = pk2(b[2 * i], b[2 * i + 1]); }
                }
                int key, ch;
                if (idx < 528) { key = idx; ch = 0; } else { const int j = idx - 528; key = j / 3; ch = 1 + (j - key * 3); }
                if (idx < 528 * 4) { *(LAS u32x4*)(Ks + key * 72 + ch * 16) = v0; *(LAS u32x4*)(Ks + key * 72 + ch * 16 + 8) = v1; }
            }
#pragma unroll
            for (int k = 0; k < 9; ++k) {
                const int idx = tid + NT * k, c8 = idx / 528, key = idx - c8 * 528;
                if (idx < 528 * 8) {
                    const u32x4 v = vr[k];
#pragma unroll
                    for (int i = 0; i < 4; ++i) { Vt[(c8 * 8 + 2 * i) * 536 + key] = (bf16_t)(v[i] & 0xffffu); Vt[(c8 * 8 + 2 * i + 1) * 536 + key] = (bf16_t)(v[i] >> 16); }
                }
            }
        }
        __syncthreads();
#pragma unroll 1
        for (int bi = 0; bi < 8; ++bi) {
            const int blk = wv + 8 * bi, g = blk >> 4, qt = blk & 15, h = kvh * 4 + g, qa = q0 + qt * 16;
            const int qpos = qa + col;
            bf16x8 qf[2];
            {
                const bf16_t* qsrc = QKV + (size_t)(row0 + qpos) * 1536 + h * 64;
                u32x4 r0 = *(const u32x4*)(qsrc + quad * 8), r1 = *(const u32x4*)(qsrc + 32 + quad * 8);
                if (quad < 2) {
                    const u32x4 ra = *(const u32x4*)(qsrc), rb = *(const u32x4*)(qsrc + 8);
                    float a[8], b[8];
#pragma unroll
                    for (int i = 0; i < 4; ++i) { a[2 * i] = __uint_as_float(ra[i] << 16); a[2 * i + 1] = __uint_as_float(ra[i] & 0xffff0000u); b[2 * i] = __uint_as_float(rb[i] << 16); b[2 * i + 1] = __uint_as_float(rb[i] & 0xffff0000u); }
                    float o[8];
                    const float* rt = RT + qpos * 16; const f32x4 c0 = *(const f32x4*)rt, c1 = *(const f32x4*)(rt + 4), s0 = *(const f32x4*)(rt + 8), s1 = *(const f32x4*)(rt + 12);
#pragma unroll
                    for (int i = 0; i < 8; ++i) { const float cs = (i < 4) ? c0[i & 3] : c1[i & 3], sn = (i < 4) ? s0[i & 3] : s1[i & 3]; o[i] = (quad == 0) ? (a[i] * cs - b[i] * sn) : (b[i] * cs + a[i] * sn); }
#pragma unroll
                    for (int i = 0; i < 4; ++i) r0[i] = pk2(o[2 * i], o[2 * i + 1]);
                }
                qf[0] = __builtin_bit_cast(bf16x8, r0); qf[1] = __builtin_bit_cast(bf16x8, r1);
            }
            const int kk0 = qt * 16;
            const float sk2 = sink[h] * LOG2E;
            f32x4 sc[18];
            float mx = -1e30f;
            sc[17] = (f32x4){-1e30f, -1e30f, -1e30f, -1e30f};
            bf16x8 kfc[2], kfn[2];
            f32x4 accp = (f32x4){0.f, 0.f, 0.f, 0.f};
#pragma unroll
            for (int ks = 0; ks < 2; ++ks) kfc[ks] = *(const LAS bf16x8*)(Ks + (kk0 + col) * 72 + ks * 32 + quad * 8);
#pragma unroll
            for (int j = 0; j <= 17; ++j) {
                if (j + 1 < 17) {
#pragma unroll
                    for (int ks = 0; ks < 2; ++ks) kfn[ks] = *(const LAS bf16x8*)(Ks + (kk0 + 16 * (j + 1) + col) * 72 + ks * 32 + quad * 8);
                }
                f32x4 acc = (f32x4){0.f, 0.f, 0.f, 0.f};
                if (j < 17) {
                    acc = __builtin_amdgcn_mfma_f32_16x16x32_bf16(kfc[0], qf[0], acc, 0, 0, 0);
                    acc = __builtin_amdgcn_mfma_f32_16x16x32_bf16(kfc[1], qf[1], acc, 0, 0, 0);
                }
                if (j >= 1) {
                    const int jj = j - 1;
                    if (jj >= 1 && jj <= 15 && !edge) {
#pragma unroll
                        for (int i = 0; i < 4; ++i) { const float tv = accp[i] * (0.125f * LOG2E); accp[i] = tv; mx = fmaxf(mx, tv); }
                    } else {
#pragma unroll
                        for (int i = 0; i < 4; ++i) {
                            const int rel = -128 + 16 * jj + 4 * quad + i - col, kpos = qpos + rel;
                            const bool valid = (rel >= -128) && (rel <= 128) && (kpos >= 0) && (kpos < L);
                            const float tv = valid ? accp[i] * (0.125f * LOG2E) : -1e30f;
                            accp[i] = tv; mx = fmaxf(mx, tv);
                        }
                    }
                    sc[jj] = accp;
                }
                accp = acc; kfc[0] = kfn[0]; kfc[1] = kfn[1];
                __builtin_amdgcn_sched_barrier(0);
            }
            mx = fmaxf(mx, __shfl_xor(mx, 16, 64)); mx = fmaxf(mx, __shfl_xor(mx, 32, 64));
            mx = fmaxf(mx, sk2);
            float sum = 0.f;
#pragma unroll
            for (int j = 0; j < 18; ++j)
#pragma unroll
                for (int i = 0; i < 4; ++i) { const float pv = __builtin_amdgcn_exp2f(sc[j][i] - mx); sc[j][i] = pv; sum += pv; }
            sum += __shfl_xor(sum, 16, 64); sum += __shfl_xor(sum, 32, 64);
            const float rden = 1.0f / (sum + __builtin_amdgcn_exp2f(sk2 - mx));
            f32x4 oacc[4];
#pragma unroll
            for (int dt = 0; dt < 4; ++dt) oacc[dt] = (f32x4){0.f, 0.f, 0.f, 0.f};
            u32x4 vfc[4], vfn[4];
#pragma unroll
            for (int dt = 0; dt < 4; ++dt) {
                const LAS bf16_t* vp = Vt + (dt * 16 + col) * 536 + kk0 + 4 * quad;
                const u32x2 lo = *(const LAS u32x2*)vp, hi = *(const LAS u32x2*)(vp + 16);
                vfc[dt].x = lo.x; vfc[dt].y = lo.y; vfc[dt].z = hi.x; vfc[dt].w = hi.y;
            }
#pragma unroll
            for (int gI = 0; gI < 9; ++gI) {
                if (gI + 1 < 9) {
#pragma unroll
                    for (int dt = 0; dt < 4; ++dt) {
                        const LAS bf16_t* vp = Vt + (dt * 16 + col) * 536 + kk0 + 32 * (gI + 1) + 4 * quad;
                        const u32x2 lo = *(const LAS u32x2*)vp, hi = *(const LAS u32x2*)(vp + 16);
                        vfn[dt].x = lo.x; vfn[dt].y = lo.y; vfn[dt].z = hi.x; vfn[dt].w = hi.y;
                    }
                }
                u32x4 pb; pb.x = pk2(sc[2 * gI][0], sc[2 * gI][1]); pb.y = pk2(sc[2 * gI][2], sc[2 * gI][3]); pb.z = pk2(sc[2 * gI + 1][0], sc[2 * gI + 1][1]); pb.w = pk2(sc[2 * gI + 1][2], sc[2 * gI + 1][3]);
                const bf16x8 pf = __builtin_bit_cast(bf16x8, pb);
#pragma unroll
                for (int dt = 0; dt < 4; ++dt) oacc[dt] = __builtin_amdgcn_mfma_f32_16x16x32_bf16(__builtin_bit_cast(bf16x8, vfc[dt]), pf, oacc[dt], 0, 0, 0);
#pragma unroll
                for (int dt = 0; dt < 4; ++dt) vfc[dt] = vfn[dt];
                __builtin_amdgcn_sched_barrier(0);
            }
            bf16_t* op = ATT + (size_t)(row0 + qpos) * 1024 + h * 64 + 4 * quad;
#pragma unroll
            for (int dt = 0; dt < 4; ++dt) { u32x2 o; o.x = pk2(oacc[dt][0] * rden, oacc[dt][1] * rden); o.y = pk2(oacc[dt][2] * rden, oacc[dt][3] * rden); *(u32x2*)(op + dt * 16) = o; }
        }
    }
}

#define XB_TMO      128
#define XB_XCNT(j)  (256  + 64 * (j))
#define XB_XSUB(j)  (1280 + 64 * (j))
#define XB_XGEN(j)  (2304 + 64 * (j))
#define XB_TOP      3328
#define XB_TOPGEN   3392
#define XCD_BAR_WORDS 3456
#define XB_SPIN_CAP (1u << 22)
__device__ __forceinline__ unsigned xb_ld(unsigned* p)              { return __hip_atomic_load(p, __ATOMIC_RELAXED, __HIP_MEMORY_SCOPE_AGENT); }
__device__ __forceinline__ unsigned xb_add(unsigned* p, unsigned v) { return __hip_atomic_fetch_add(p, v, __ATOMIC_RELAXED, __HIP_MEMORY_SCOPE_AGENT); }
__device__ __forceinline__ unsigned xb_xcc_id() { return (unsigned)__builtin_amdgcn_s_getreg((3 << 11) | 20) & 0xFu; }
#define XB_SPIN(cond, bar) do { unsigned _sp = 0; while (cond) { __builtin_amdgcn_s_sleep(1); \
    if ((++_sp & 255u) == 0u) { if (xb_ld(&(bar)[XB_TMO])) break; if (_sp > XB_SPIN_CAP) { atomicAdd(&(bar)[XB_TMO], 1u); break; } } } } while (0)
struct XcdBarrier { unsigned* bar; unsigned x; volatile LAS unsigned* st; };
__device__ __forceinline__ XcdBarrier xcd_barrier_post(unsigned* bar, volatile LAS unsigned* st) {
    XcdBarrier b; b.bar = bar; b.x = xb_xcc_id(); b.st = st;
    if (threadIdx.x == 0) (void)xb_add(&bar[XB_XCNT(b.x)], 1u);
    return b;
}
__device__ __forceinline__ void xcd_barrier_complete(unsigned* bar, unsigned x, unsigned& nloc, unsigned& nx) {
    const unsigned G = gridDim.x * gridDim.y * gridDim.z;
    unsigned sum, cnt, mine, sp = 0u;
    for (;;) {
        sum = 0u; cnt = 0u; mine = 0u;
#pragma unroll
        for (unsigned j = 0; j < 16; ++j) { const unsigned c = xb_ld(&bar[XB_XCNT(j)]); sum += c; cnt += (c > 0u) ? 1u : 0u; mine = (j == x) ? c : mine; }
        if (sum == G) break;
        __builtin_amdgcn_s_sleep(1);
        if ((++sp & 255u) == 0u) { if (xb_ld(&bar[XB_TMO])) break; if (sp > XB_SPIN_CAP) { atomicAdd(&bar[XB_TMO], 1u); break; } }
    }
    nloc = mine > 0u ? mine : 1u; nx = cnt > 0u ? cnt : 1u;
}
__device__ __forceinline__ void xcd_barrier(const XcdBarrier& b) {
    asm volatile("s_waitcnt vmcnt(0)" ::: "memory");
    __syncthreads();
    if (threadIdx.x == 0) {
        unsigned* bar = b.bar;
        __builtin_amdgcn_s_waitcnt(0);
        unsigned nloc = b.st[0], nx = b.st[1];
        if (nloc == 0u) { xcd_barrier_complete(bar, b.x, nloc, nx); b.st[0] = nloc; b.st[1] = nx; }
        const unsigned old = xb_add(&bar[XB_XSUB(b.x)], 1u);
        const unsigned gen = old / nloc;
        if (old + 1u == (gen + 1u) * nloc) {
            __builtin_amdgcn_fence(__ATOMIC_RELEASE, "agent");
            asm volatile("s_waitcnt vmcnt(0)" ::: "memory");
            const unsigned og = xb_add(&bar[XB_TOP], 1u);
            const unsigned tg = og / nx;
            if (og + 1u == (tg + 1u) * nx) xb_add(&bar[XB_TOPGEN], 1u);
            else XB_SPIN(xb_ld(&bar[XB_TOPGEN]) == tg, bar);
            __builtin_amdgcn_fence(__ATOMIC_ACQUIRE, "agent");
            xb_add(&bar[XB_XGEN(b.x)], 1u);
            asm volatile("s_waitcnt vmcnt(0)" ::: "memory");
        } else {
            XB_SPIN(xb_ld(&bar[XB_XGEN(b.x)]) == gen, bar);
            __builtin_amdgcn_fence(__ATOMIC_ACQUIRE, "agent");
            asm volatile("s_waitcnt vmcnt(0)" ::: "memory");
        }
    }
    __syncthreads();
}

constexpr int NPH = 19;
__global__ void __launch_bounds__(NT) mk_fwd(Params p) {
    extern __shared__ __attribute__((aligned(16))) unsigned char lds_raw[];
    LAS unsigned char* lds = (LAS unsigned char*)lds_raw;
    volatile LAS unsigned* xbst = (volatile LAS unsigned*)(lds + LDS_BYTES - 16);
    if (threadIdx.x == 0) { xbst[0] = 0u; xbst[1] = 0u; }
    __syncthreads();
    XcdBarrier xb{};
    if (p.ph_hi - p.ph_lo > 1) xb = xcd_barrier_post((unsigned*)(p.ws + OFF_BAR), xbst);
    bf16_t* R0 = (bf16_t*)(p.ws + OFF_HN);
    bf16_t* R1 = (bf16_t*)(p.ws + OFF_BIG);
    bf16_t* DO = (bf16_t*)p.out;
    float* SS = (float*)(p.ws + OFF_SS);
#if PROBE_MASK
    unsigned long long pr_acc = 0ull;
#endif
    for (int ph = p.ph_lo; ph < p.ph_hi; ++ph) {
#if PROBE_MASK
        const unsigned long long pr_t0 = __builtin_amdgcn_s_memrealtime();
#endif
        int kind = 0;
        pg8::Gemm g{}; pg8::EpiBf eb{}; pg8::EpiRes er{};
        if (ph == 0) kind = 10;
        else if (ph == 1) { kind = 2; g = pg8::Gemm{R0, (bf16_t*)(p.ws + OFF_WIN), NTOK, 2560, 1024}; eb = pg8::EpiBf{2, DO, 512, DO + (size_t)NTOK * 512, SS, 0}; }
        else if (ph == 2) kind = 11;
        else if (ph == 3) kind = 16;
        else if (ph == 4) kind = 12;
        else if (ph == 5) kind = 13;
        else if (ph == 6) { kind = 3; g = pg8::Gemm{R0, (bf16_t*)(p.ws + OFF_WOUT), NTOK, 1024, 1024}; er = pg8::EpiRes{p.in[0], p.in[1], nullptr, R1, 0, SS + 65536}; }
        else if ((ph >= 7 && ph <= 10) || (ph >= 14 && ph <= 17)) {
            const int layer = (ph >= 14), i = ph - (layer ? 14 : 7), h = i >> 1;
            if ((i & 1) == 0) { kind = 2; g = pg8::Gemm{R1 + (size_t)h * 32768 * 1024, (bf16_t*)(p.ws + OFF_WUP) + (size_t)layer * N_WFF, 32768, 4096, 1024};
                eb = pg8::EpiBf{1, DO, 4096, nullptr, SS + (layer ? 3 : 1) * 65536, h * 32768}; }
            else { kind = 3; g = pg8::Gemm{DO, (bf16_t*)(p.ws + OFF_WDN) + (size_t)layer * N_WFF, 32768, 1024, 4096};
                er = pg8::EpiRes{nullptr, nullptr, R1, layer ? R1 : R0, h * 32768, SS + (layer ? 4 : 2) * 65536}; }
        }
        else if (ph == 11) { kind = 2; g = pg8::Gemm{R0, (bf16_t*)(p.ws + OFF_WQKV), NTOK, 1536, 1024}; eb = pg8::EpiBf{0, R1, 1536, nullptr, SS + 2 * 65536, 0}; }
        else if (ph == 12) kind = 14;
        else if (ph == 13) { kind = 3; g = pg8::Gemm{DO, (bf16_t*)(p.ws + OFF_WO), NTOK, 1024, 1024}; er = pg8::EpiRes{nullptr, nullptr, R0, R1, 0, SS + 3 * 65536}; }
        else kind = 15;
        if (kind == 2) { pg8::StaticOrder S; S.init(g.M, g.N, gridDim.x, blockIdx.x); pg8::gemm_phase<pg8::EpiBf>(lds, g, S, eb); }
        else if (kind == 3) { pg8::StaticOrder S; S.init(g.M, g.N, gridDim.x, blockIdx.x); pg8::gemm_phase<pg8::EpiRes>(lds, g, S, er); }
        else if (kind == 10) { phase_weights(p, (LAS float*)lds); phase_filter_hidden(p, (LAS float*)lds); phase_rope_table(p); phase_prep_x(p); }
        else if (kind == 11) { phase_conformer(p, lds); phase_shortconv_T(p, (LAS float*)lds); }
        else if (kind == 12) phase_hyena(p, lds);
        else if (kind == 13) phase_zT(p, (LAS float*)lds);
        else if (kind == 14) phase_attn(p, lds);
        else if (kind == 15) phase_final_norm(p);
        else if (kind == 16) phase_filters(p, lds);
        if (ph + 1 < p.ph_hi) { if (p.ph_hi > 1000) cg::this_grid().sync();   xcd_barrier(xb); }
#if PROBE_MASK
        if ((PROBE_MASK >> ph) & 1u) pr_acc += __builtin_amdgcn_s_memrealtime() - pr_t0;
#endif
    }
#if PROBE_MASK
    if (blockIdx.x == 0 && threadIdx.x == 0) { const unsigned long long t1 = __builtin_amdgcn_s_memrealtime(); while (__builtin_amdgcn_s_memrealtime() - t1 < PROBE_MULT * pr_acc) __builtin_amdgcn_s_sleep(8); }
#endif
}

extern "C" void kernel_launch(void* const* d_in, const int* in_sizes, int n_in, void* d_out, int out_size, void* d_ws, size_t ws_size, hipStream_t stream) {
    static int grid = 0;
    if (grid == 0) {
        if (n_in != 28 || ws_size < WS_END) { fprintf(stderr, "kernel_launch: unexpected n_in %d / ws_size %zu (need %zu)\n", n_in, ws_size, (size_t)WS_END); grid = -1; return; }
        int dev = 0, cus = 0, per_cu = 0;
        hipGetDevice(&dev); hipDeviceGetAttribute(&cus, hipDeviceAttributeMultiprocessorCount, dev);
        if (hipFuncSetAttribute((const void*)mk_fwd, hipFuncAttributeMaxDynamicSharedMemorySize, LDS_BYTES) != hipSuccess) { fprintf(stderr, "kernel_launch: hipFuncSetAttribute failed\n"); grid = -1; return; }
        hipOccupancyMaxActiveBlocksPerMultiprocessor(&per_cu, (const void*)mk_fwd, NT, LDS_BYTES);
        if (per_cu < 1) { fprintf(stderr, "kernel_launch: occupancy query says %d blocks per CU\n", per_cu); per_cu = 1; }
        (void)hipGetLastError();
        grid = cus > 256 ? 256 : cus;
    }
    if (grid < 0) return;
    Params p{};
    for (int i = 0; i < 28; ++i) p.in[i] = (const float*)d_in[i];
    p.out = (float*)d_out; p.ws = (unsigned char*)d_ws;
#if MK_MULTI
    for (int ph = 0; ph < NPH; ++ph) {
        p.ph_lo = ph; p.ph_hi = ph + 1;
        hipLaunchKernelGGL(mk_fwd, dim3(grid), dim3(NT), LDS_BYTES, stream, p);
    }
#else
    p.ph_lo = 0; p.ph_hi = NPH;
    if (hipMemsetAsync((char*)d_ws + OFF_BAR, 0, XCD_BAR_BYTES, stream) != hipSuccess) { fprintf(stderr, "kernel_launch: memset of barrier words failed\n"); return; }
    void* args[] = {&p};
    hipError_t e = hipLaunchCooperativeKernel((const void*)mk_fwd, dim3(grid), dim3(NT), args, LDS_BYTES, stream);
    if (e != hipSuccess) fprintf(stderr, "cooperative launch failed: %s (grid %d)\n", hipGetErrorString(e), grid);
#endif
}
#endif
```
